# Optimizing an MI355X kernel written in HIP

```python
import math
import jax, jax.numpy as jnp
from jax import lax
import numpy as np

D_MODEL = 2048
BATCH = 4
SEQ = 2048
DEPTH = 2
DEC_BATCH = 128
DEC_SEQ = 1
PAST_LEN = 16384
PAGE_SIZE = 128

N_MIXERS = 2
N_DELTA_LAYERS = (DEPTH + 1) // 2
N_SSM_LAYERS = DEPTH // 2
RMS_EPS = 1e-6

GDN_QK_HEADS = 16
GDN_V_HEADS = 32
GDN_DK = 128
GDN_DV = 128
GDN_KEY_DIM = GDN_QK_HEADS * GDN_DK
GDN_VAL_DIM = GDN_V_HEADS * GDN_DV
GDN_CONV_DIM = 2 * GDN_KEY_DIM + GDN_VAL_DIM
GDN_CONV_W = 4
GDN_CHUNK = 64
GDN_IN_DIM = GDN_CONV_DIM + GDN_VAL_DIM + 2 * GDN_V_HEADS

SSM_EXPAND = 2
SSM_WIDTH = SSM_EXPAND * D_MODEL
SSM_GROUP = 16
SSM_GROUPS = SSM_WIDTH // SSM_GROUP
SSM_STATE = 64
SSM_BLOCK = 256
DT_MIN = 1e-3
DT_MAX = 1e-1

kernel_name = "gdn_s5_hybrid_step"


def rms_norm(x, g):
    xf = x.astype(jnp.float32)
    y = xf * lax.rsqrt(jnp.mean(xf * xf, axis=-1, keepdims=True) + RMS_EPS)
    return (y * g.astype(jnp.float32)).astype(x.dtype)


def l2_normalize(x):
    xf = x.astype(jnp.float32)
    return xf * lax.rsqrt(jnp.sum(xf * xf, axis=-1, keepdims=True) + 1e-6)


def causal_conv_silu(x, buf, w):
    T = x.shape[1]
    xp = jnp.concatenate([buf.astype(x.dtype), x], axis=1)
    y = xp[:, 0:T] * w[0]
    for j in range(1, GDN_CONV_W):
        y = y + xp[:, j:j + T] * w[j]
    return jax.nn.silu(y), xp[:, -(GDN_CONV_W - 1):]


def gated_delta_rule(q, k, v, g, beta, s0):
    Bsz, T, H, _ = q.shape
    C = min(GDN_CHUNK, T)
    n = -(-T // C)
    pad = n * C - T

    def prep(a):
        a = jnp.pad(a.astype(jnp.float32), [(0, 0), (0, pad)] + [(0, 0)] * (a.ndim - 2))
        a = a.reshape((Bsz, n, C) + a.shape[2:])
        return jnp.moveaxis(a, 3, 1)

    q, k, v, g, beta = prep(q), prep(k), prep(v), prep(g), prep(beta)
    dv = v.shape[-1]
    gc = jnp.cumsum(g, axis=-1)
    causal = jnp.tril(jnp.ones((C, C), bool))
    strict = jnp.tril(jnp.ones((C, C), bool), -1)
    decay = jnp.exp(jnp.where(causal, gc[..., :, None] - gc[..., None, :], -jnp.inf))
    kb = k * beta[..., None]
    lower = jnp.where(strict, jnp.einsum('bhncd,bhnsd->bhncs', kb, k) * decay, 0.0)
    eye = jnp.eye(C, dtype=jnp.float32)
    rhs = jnp.concatenate([v * beta[..., None], kb * jnp.exp(gc)[..., None]], axis=-1)
    sol = lax.linalg.triangular_solve(lower + eye, rhs, left_side=True, lower=True)
    u, w = sol[..., :dv], sol[..., dv:]
    attn = jnp.einsum('bhncd,bhnsd->bhncs', q, k) * decay
    q_dec = q * jnp.exp(gc)[..., None]
    k_dec = k * jnp.exp(gc[..., -1:] - gc)[..., None]
    g_last = jnp.exp(gc[..., -1])
    xs = tuple(jnp.moveaxis(a, 2, 0) for a in (u, w, attn, q_dec, k_dec, g_last))

    def step(S, inp):
        u_c, w_c, a_c, qd_c, kd_c, gl_c = inp
        v_new = u_c - jnp.einsum('bhcd,bhde->bhce', w_c, S)
        o = jnp.einsum('bhcd,bhde->bhce', qd_c, S) + jnp.einsum('bhcs,bhse->bhce', a_c, v_new)
        S = S * gl_c[..., None, None] + jnp.einsum('bhcd,bhce->bhde', kd_c, v_new)
        return S, o

    S, o = lax.scan(step, s0.astype(jnp.float32), xs)
    o = jnp.transpose(o, (1, 0, 3, 2, 4)).reshape(Bsz, n * C, H, dv)[:, :T]
    return o, S


def gdn_branch(h, conv_buf, s0, w_in, conv_w, a_log, dt_bias, o_gain, w_out):
    Bsz, T, _ = h.shape
    f32 = jnp.float32
    proj = h @ w_in
    i1 = GDN_CONV_DIM
    i2 = i1 + GDN_VAL_DIM
    i3 = i2 + GDN_V_HEADS
    qkv, z, b, a = jnp.split(proj, [i1, i2, i3], axis=-1)
    qkv, new_buf = causal_conv_silu(qkv, conv_buf, conv_w)
    q, k, v = jnp.split(qkv, [GDN_KEY_DIM, 2 * GDN_KEY_DIM], axis=-1)
    rep = GDN_V_HEADS // GDN_QK_HEADS
    q = jnp.repeat(l2_normalize(q.reshape(Bsz, T, GDN_QK_HEADS, GDN_DK)), rep, axis=2) * (GDN_DK ** -0.5)
    k = jnp.repeat(l2_normalize(k.reshape(Bsz, T, GDN_QK_HEADS, GDN_DK)), rep, axis=2)
    v = v.reshape(Bsz, T, GDN_V_HEADS, GDN_DV)
    beta = jax.nn.sigmoid(b.astype(f32))
    g = -jnp.exp(a_log.astype(f32)) * jax.nn.softplus(a.astype(f32) + dt_bias.astype(f32))
    o, s_new = gated_delta_rule(q, k, v, g, beta, s0)
    zg = z.reshape(Bsz, T, GDN_V_HEADS, GDN_DV).astype(f32)
    o = o * lax.rsqrt(jnp.mean(o * o, axis=-1, keepdims=True) + RMS_EPS) * o_gain.astype(f32) * jax.nn.silu(zg)
    out = o.reshape(Bsz, T, GDN_VAL_DIM).astype(h.dtype) @ w_out
    return out, new_buf, s_new


def s5_branch(h, h0_re, h0_im, w_in, lam_re, lam_im, b_re, b_im, c_re, c_im, d_skip, log_dt, w_glu, b_glu, w_out):
    Bsz, T, _ = h.shape
    f32 = jnp.float32
    u, z = jnp.split(h @ w_in, 2, axis=-1)
    lam = lax.complex(jnp.minimum(lam_re.astype(f32), -1e-4), lam_im.astype(f32))
    dt = jnp.exp(log_dt.astype(f32))[:, None]
    a_bar = jnp.exp(lam * dt)
    b_bar = ((a_bar - 1.0) / lam)[..., None] * lax.complex(b_re.astype(f32), b_im.astype(f32))
    cmat = lax.complex(c_re.astype(f32), c_im.astype(f32))
    blk = math.gcd(T, SSM_BLOCK)
    nb = T // blk
    ub = jnp.moveaxis(u.astype(f32).reshape(Bsz, nb, blk, SSM_GROUPS, SSM_GROUP), 1, 0)

    def combine(e1, e2):
        a1, b1 = e1
        a2, b2 = e2
        return a2 * a1, a2 * b1 + b2

    def block(hc, u_blk):
        bu = jnp.einsum('gpc,btgc->btgp', b_bar, u_blk)
        bu = bu.at[:, 0].add(a_bar * hc)
        _, hs = lax.associative_scan(combine, (jnp.broadcast_to(a_bar, bu.shape), bu), axis=1)
        y = jnp.real(jnp.einsum('gcp,btgp->btgc', cmat, hs))
        return hs[:, -1], y

    hc0 = lax.complex(h0_re.astype(f32), h0_im.astype(f32))
    h_last, y = lax.scan(block, hc0, ub)
    y = jnp.moveaxis(y, 0, 1).reshape(Bsz, T, SSM_WIDTH) + d_skip.astype(f32) * u.astype(f32)
    y = jax.nn.gelu(y)
    y = y * jax.nn.sigmoid((y.astype(h.dtype) @ w_glu + b_glu).astype(f32))
    y = y * jax.nn.silu(z.astype(f32))
    out = y.astype(h.dtype) @ w_out
    return out, jnp.real(h_last), jnp.imag(h_last)


def trunk(x, conv0, delta0, re0, im0, gdn_w, ssm_w, norm_final):
    (norm_gdn, w_in_gdn, conv_gdn, a_log_gdn, dt_bias_gdn, onorm_gdn, w_out_gdn) = gdn_w
    (norm_ssm, w_in_ssm, lam_re, lam_im, b_re, b_im, c_re, c_im, d_ssm, log_dt_ssm,
     w_glu_ssm, b_glu_ssm, w_out_ssm) = ssm_w
    convs, deltas, res, ims = [], [], [], []
    for i in range(DEPTH):
        j = i // N_MIXERS
        if i % N_MIXERS == 0:
            h = rms_norm(x, norm_gdn[j])
            out, cb, ds = gdn_branch(h, conv0[j], delta0[j], w_in_gdn[j], conv_gdn[j], a_log_gdn[j],
                                     dt_bias_gdn[j], onorm_gdn[j], w_out_gdn[j])
            convs.append(cb)
            deltas.append(ds)
        else:
            h = rms_norm(x, norm_ssm[j])
            out, hr, hi = s5_branch(h, re0[j], im0[j], w_in_ssm[j], lam_re[j], lam_im[j], b_re[j], b_im[j],
                                    c_re[j], c_im[j], d_ssm[j], log_dt_ssm[j], w_glu_ssm[j], b_glu_ssm[j],
                                    w_out_ssm[j])
            res.append(hr)
            ims.append(hi)
        x = x + out.astype(x.dtype)
    y = rms_norm(x, norm_final)
    return y, jnp.stack(convs), jnp.stack(deltas), jnp.stack(res), jnp.stack(ims)


def setup_inputs(seed: int = 0) -> dict:
    key = jax.random.key(seed)
    ks = jax.random.split(key, 32)
    f32 = jnp.float32
    nrm = lambda k, s, sc: jax.random.normal(k, s, f32) * sc
    NA, NB = N_DELTA_LAYERS, N_SSM_LAYERS
    dt0 = jnp.exp(jax.random.uniform(ks[10], (NA, GDN_V_HEADS), f32, math.log(DT_MIN), math.log(DT_MAX)))
    lam_im = jnp.pi * jnp.arange(SSM_STATE, dtype=f32) + nrm(ks[16], (NB, SSM_GROUPS, SSM_STATE), 0.01)
    return {
        "x_prompt": nrm(ks[0], (BATCH, SEQ, D_MODEL), 1.0),
        "x_sample": nrm(ks[1], (DEC_BATCH, DEC_SEQ, D_MODEL), 1.0),
        "state_gdn_conv": nrm(ks[2], (NA, DEC_BATCH, GDN_CONV_W - 1, GDN_CONV_DIM), 1.0),
        "state_gdn_delta": nrm(ks[3], (NA, DEC_BATCH, GDN_V_HEADS, GDN_DK, GDN_DV), GDN_DK ** -0.5),
        "state_ssm_re": nrm(ks[4], (NB, DEC_BATCH, SSM_GROUPS, SSM_STATE), 0.5),
        "state_ssm_im": nrm(ks[5], (NB, DEC_BATCH, SSM_GROUPS, SSM_STATE), 0.5),
        "norm_gdn": 1.0 + nrm(ks[6], (NA, D_MODEL), 0.02),
        "w_in_gdn": nrm(ks[7], (NA, D_MODEL, GDN_IN_DIM), D_MODEL ** -0.5),
        "conv_gdn": nrm(ks[8], (NA, GDN_CONV_W, GDN_CONV_DIM), GDN_CONV_W ** -0.5),
        "a_log_gdn": jnp.log(jax.random.uniform(ks[9], (NA, GDN_V_HEADS), f32, 1.0, 16.0)),
        "dt_bias_gdn": dt0 + jnp.log(-jnp.expm1(-dt0)),
        "onorm_gdn": 1.0 + nrm(ks[11], (NA, GDN_DV), 0.02),
        "w_out_gdn": nrm(ks[12], (NA, GDN_VAL_DIM, D_MODEL), GDN_VAL_DIM ** -0.5),
        "norm_ssm": 1.0 + nrm(ks[13], (NB, D_MODEL), 0.02),
        "w_in_ssm": nrm(ks[14], (NB, D_MODEL, 2 * SSM_WIDTH), D_MODEL ** -0.5),
        "lam_re": -0.5 + nrm(ks[15], (NB, SSM_GROUPS, SSM_STATE), 0.01),
        "lam_im": lam_im,
        "b_re": nrm(ks[17], (NB, SSM_GROUPS, SSM_STATE, SSM_GROUP), (2 * SSM_GROUP) ** -0.5),
        "b_im": nrm(ks[18], (NB, SSM_GROUPS, SSM_STATE, SSM_GROUP), (2 * SSM_GROUP) ** -0.5),
        "c_re": nrm(ks[19], (NB, SSM_GROUPS, SSM_GROUP, SSM_STATE), SSM_STATE ** -0.5),
        "c_im": nrm(ks[20], (NB, SSM_GROUPS, SSM_GROUP, SSM_STATE), SSM_STATE ** -0.5),
        "d_ssm": nrm(ks[21], (NB, SSM_WIDTH), 1.0),
        "log_dt_ssm": jax.random.uniform(ks[22], (NB, SSM_GROUPS), f32, math.log(DT_MIN), math.log(DT_MAX)),
        "w_glu_ssm": nrm(ks[23], (NB, SSM_WIDTH, SSM_WIDTH), SSM_WIDTH ** -0.5),
        "b_glu_ssm": nrm(ks[24], (NB, SSM_WIDTH), 0.01),
        "w_out_ssm": nrm(ks[25], (NB, SSM_WIDTH, D_MODEL), SSM_WIDTH ** -0.5),
        "norm_final": 1.0 + nrm(ks[26], (D_MODEL,), 0.02),
    }


def reference(x_prompt, x_sample, state_gdn_conv, state_gdn_delta, state_ssm_re, state_ssm_im,
              norm_gdn, w_in_gdn, conv_gdn, a_log_gdn, dt_bias_gdn, onorm_gdn, w_out_gdn,
              norm_ssm, w_in_ssm, lam_re, lam_im, b_re, b_im, c_re, c_im, d_ssm, log_dt_ssm,
              w_glu_ssm, b_glu_ssm, w_out_ssm, norm_final):
    gdn_w = (norm_gdn, w_in_gdn, conv_gdn, a_log_gdn, dt_bias_gdn, onorm_gdn, w_out_gdn)
    ssm_w = (norm_ssm, w_in_ssm, lam_re, lam_im, b_re, b_im, c_re, c_im, d_ssm, log_dt_ssm,
             w_glu_ssm, b_glu_ssm, w_out_ssm)
    Bp = x_prompt.shape[0]
    conv_p0 = jnp.zeros((N_DELTA_LAYERS, Bp, GDN_CONV_W - 1, GDN_CONV_DIM), x_prompt.dtype)
    delta_p0 = jnp.zeros((N_DELTA_LAYERS, Bp, GDN_V_HEADS, GDN_DK, GDN_DV), jnp.float32)
    ssm_p0 = jnp.zeros((N_SSM_LAYERS, Bp, SSM_GROUPS, SSM_STATE), jnp.float32)
    y_prompt, conv_p, delta_p, re_p, im_p = trunk(x_prompt, conv_p0, delta_p0, ssm_p0, ssm_p0,
                                                  gdn_w, ssm_w, norm_final)
    y_sample, conv_s, delta_s, re_s, im_s = trunk(x_sample, state_gdn_conv, state_gdn_delta, state_ssm_re,
                                                  state_ssm_im, gdn_w, ssm_w, norm_final)
    return (y_prompt, y_sample, conv_p, delta_p, re_p, im_p, conv_s, delta_s, re_s, im_s)
```

```cpp
#include <hip/hip_runtime.h>
#include <hip/hip_cooperative_groups.h>
#include <cstdio>
#include <cstdint>
namespace cg = cooperative_groups;
namespace pg8 {
#define PG8_LAS __attribute__((address_space(3)))
typedef unsigned short bf16_t;
typedef short bf16x8 __attribute__((ext_vector_type(8)));
typedef float f32x4 __attribute__((ext_vector_type(4)));
typedef unsigned u32x4 __attribute__((ext_vector_type(4)));
constexpr int BM = 256, BK = 64, HALF = 128, HTB = HALF * BK * 2  , STAGE_BYTES = 8 * HTB, NXCD = 8, WGM = 16;

__host__ __device__ __forceinline__ int lds_byte(int r, int c) { const int st = (r >> 4) * 2 + (c >> 5), rr = r & 15, cc = c & 31, ob = rr * 64 + cc * 2; return st * 1024 + (ob ^ (((ob >> 9) & 1) << 5)); }
__host__ __device__ __forceinline__ void stage_rc(int b, int& R, int& C) { const int st = b / 1024, sb = b % 1024, swz = sb ^ (((sb >> 9) & 1) << 5); R = (st >> 1) * 16 + swz / 64; C = (st & 1) * 32 + (swz % 64) / 2; }
__host__ __device__ __forceinline__ int perm32(int rho) { const int n = rho >> 4, i = rho & 15; return 8 * (i >> 2) + 4 * n + (i & 3); }

struct Unit { int pm, pn; };
struct Gemm { const bf16_t* A; const bf16_t* Bt; int M, N, K; };

struct StaticOrder {
    int nM, nN, nwg, G, c;
    __host__ __device__ void init(int M, int N, int G_, int c_) { nM = M / BM; nN = N / BM; nwg = nM * nN; G = G_; c = c_; }
    __host__ __device__ bool next(int i, Unit& u) const {
        const long L = (long)i * G + c; if (L >= nwg) return false;
        int wgid = (int)L; { const int q = nwg / NXCD, r = nwg % NXCD, xcd = wgid % NXCD, off = wgid / NXCD; wgid = (xcd < r ? xcd * (q + 1) : r * (q + 1) + (xcd - r) * q) + off; }
        const int nig = WGM * nN, gid = wgid / nig, fm = gid * WGM, gsz = (nM - fm) < WGM ? (nM - fm) : WGM;
        u.pm = fm + ((wgid % nig) % gsz); u.pn = (wgid % nig) / gsz; return true;
    }
    __device__ __forceinline__ void a_ready(const Unit&) const {}
    __device__ __forceinline__ void done(const Unit&) const {}
};

__device__ __forceinline__ unsigned cvt_pk_bf16(float lo, float hi) { unsigned r; asm volatile("v_cvt_pk_bf16_f32 %0, %1, %2" : "=v"(r) : "v"(lo), "v"(hi)); return r; }

template <class Epi, class Sched, bool ALIGN_EPI = false, bool SP2 = false>
__device__ __forceinline__ void gemm_phase(PG8_LAS unsigned char* lds, const Gemm g, const Sched& S, const Epi& E) {
    const int tid = threadIdx.x, wid = __builtin_amdgcn_readfirstlane(tid >> 6), lane = tid & 63, wr = wid >> 2, wc = wid & 3, fr = lane & 15, fq = lane >> 4;
    const int K = g.K, nt = K / BK;
    unsigned voffA[2], voffB[2];
#pragma unroll
    for (int i = 0; i < 2; ++i) { int R, C; stage_rc(tid * 16 + i * 8192, R, C); const int Rb = Epi::PERM ? ((R & ~31) + perm32(R & 31)) : R;
        voffA[i] = (unsigned)(R * K + C) * 2u; voffB[i] = (unsigned)(Rb * K + C) * 2u; }
    const size_t kstep = (size_t)(BK * 2);
    const size_t hstep = (size_t)HALF * K * 2;
    const size_t tstep = 2 * hstep;
    const unsigned ldsw = (unsigned)wid * 1024u;
    const int aoff = lds_byte(wr * 64 + fr, fq * 8), boff = lds_byte(wc * 32 + fr, fq * 8);
#define PG8_SA(b, h) (((b) * 2 + (h)) * HTB)
#define PG8_SB(b, h) ((4 + (b) * 2 + (h)) * HTB)
#define PG8_STAGE(bufoff, gbase, voff) do { _Pragma("unroll") for (int _i = 0; _i < 2; ++_i) \
        __builtin_amdgcn_global_load_lds((const unsigned*)((const char*)(gbase) + (voff)[_i]), (PG8_LAS unsigned*)(lds + (bufoff) + ldsw + _i * 8192), 16, 0, 0); } while (0)
#define PG8_LDA(dst, b, h) do { _Pragma("unroll") for (int m = 0; m < 4; ++m) _Pragma("unroll") for (int k = 0; k < 2; ++k) dst[m][k] = *(const PG8_LAS bf16x8*)(lds + PG8_SA(b, h) + aoff + m * 2048 + k * 1024); } while (0)
#define PG8_LDB(dst, b, h) do { _Pragma("unroll") for (int n = 0; n < 2; ++n) _Pragma("unroll") for (int k = 0; k < 2; ++k) dst[n][k] = *(const PG8_LAS bf16x8*)(lds + PG8_SB(b, h) + boff + n * 2048 + k * 1024); } while (0)
#define PG8_MMA(ai, bj, At, Bt) do { __builtin_amdgcn_s_setprio(1); _Pragma("unroll") for (int m = 0; m < 4; ++m) _Pragma("unroll") for (int n = 0; n < 2; ++n) _Pragma("unroll") for (int k = 0; k < 2; ++k) \
        acc[ai][bj][m][n] = __builtin_amdgcn_mfma_f32_16x16x32_bf16(Bt[n][k], At[m][k], acc[ai][bj][m][n], 0, 0, 0); __builtin_amdgcn_s_setprio(0); } while (0)
#define PG8_WAIT_V(n) asm volatile("s_waitcnt vmcnt(" #n ")" ::: "memory")
#define PG8_WAIT_L(n) asm volatile("s_waitcnt lgkmcnt(" #n ")" ::: "memory")
#define PG8_BAR __builtin_amdgcn_s_barrier()
#define PG8_SCHED __builtin_amdgcn_sched_barrier(0)
    Unit cur, nxt; int ui = 0;
    if (!S.next(0, cur)) return;
    f32x4 acc[2][2][4][2];
#pragma unroll
    for (int a = 0; a < 2; ++a)
#pragma unroll
        for (int b = 0; b < 2; ++b)
#pragma unroll
            for (int m = 0; m < 4; ++m)
#pragma unroll
                for (int n = 0; n < 2; ++n) acc[a][b][m][n] = (f32x4){0.f, 0.f, 0.f, 0.f};
    bf16x8 At[4][2], B0[2][2], B1[2][2];
    const char* cA = (const char*)g.A + (size_t)cur.pm * tstep; const char* cB = (const char*)g.Bt + (size_t)cur.pn * tstep;
    S.a_ready(cur);
    if constexpr (SP2) {
        PG8_STAGE(PG8_SB(0, 0), cB, voffB); PG8_STAGE(PG8_SB(0, 1), cB + hstep, voffB); PG8_STAGE(PG8_SA(0, 0), cA, voffA); PG8_STAGE(PG8_SA(0, 1), cA + hstep, voffA);
        if (wr == 1) PG8_BAR;
        PG8_WAIT_V(2); PG8_BAR;
        PG8_STAGE(PG8_SB(1, 0), cB + kstep, voffB); PG8_STAGE(PG8_SA(1, 0), cA + kstep, voffA); PG8_STAGE(PG8_SB(1, 1), cB + hstep + kstep, voffB);
        PG8_WAIT_V(6); PG8_BAR;
    } else {
        PG8_STAGE(PG8_SB(0, 0), cB, voffB); PG8_STAGE(PG8_SA(0, 0), cA, voffA); PG8_STAGE(PG8_SB(0, 1), cB + hstep, voffB); PG8_STAGE(PG8_SA(0, 1), cA + hstep, voffA);
        if (wr == 1) PG8_BAR;
        PG8_WAIT_V(4); PG8_BAR;
        PG8_STAGE(PG8_SB(1, 0), cB + kstep, voffB); PG8_STAGE(PG8_SA(1, 0), cA + kstep, voffA); PG8_STAGE(PG8_SB(1, 1), cB + hstep + kstep, voffB);
        PG8_WAIT_V(6); PG8_BAR;
    }
    for (;;) {
        const bool has_next = S.next(ui + 1, nxt);
        const char* nA = has_next ? (const char*)g.A + (size_t)nxt.pm * tstep : cA; const char* nB = has_next ? (const char*)g.Bt + (size_t)nxt.pn * tstep : cB;
        for (int t = 0; t < nt; t += 2) {
            const bool last = (t == nt - 2);
            const char* a1 = cA + (size_t)(t + 1) * kstep;
            const char* a2 = last ? nA : cA + (size_t)(t + 2) * kstep; const char* b2 = last ? nB : cB + (size_t)(t + 2) * kstep;
            const char* a3 = a2 + kstep; const char* b3 = b2 + kstep;
            if (last && has_next) S.a_ready(nxt);
            if constexpr (SP2) {
            PG8_LDB(B0, 0, 0); PG8_LDB(B1, 0, 1); PG8_SCHED; PG8_LDA(At, 0, 0); PG8_STAGE(PG8_SA(1, 1), a1 + hstep, voffA);
            PG8_WAIT_V(8); PG8_WAIT_L(0); PG8_BAR; PG8_MMA(0, 0, At, B0); PG8_MMA(0, 1, At, B1); PG8_BAR; PG8_SCHED;
            PG8_LDA(At, 0, 1); PG8_STAGE(PG8_SB(0, 0), b2, voffB); PG8_STAGE(PG8_SB(0, 1), b2 + hstep, voffB); PG8_STAGE(PG8_SA(0, 0), a2, voffA);
            PG8_WAIT_V(8); PG8_WAIT_L(0); PG8_BAR; PG8_MMA(1, 0, At, B0); PG8_MMA(1, 1, At, B1); PG8_BAR; PG8_SCHED;
            PG8_LDB(B0, 1, 0); PG8_LDB(B1, 1, 1); PG8_SCHED; PG8_LDA(At, 1, 0); PG8_STAGE(PG8_SA(0, 1), a2 + hstep, voffA);
            PG8_WAIT_V(8); PG8_WAIT_L(0); PG8_BAR; PG8_MMA(0, 0, At, B0); PG8_MMA(0, 1, At, B1); PG8_BAR; PG8_SCHED;
            PG8_LDA(At, 1, 1); PG8_STAGE(PG8_SB(1, 0), b3, voffB); PG8_STAGE(PG8_SB(1, 1), b3 + hstep, voffB); PG8_STAGE(PG8_SA(1, 0), a3, voffA);
            PG8_WAIT_V(8); PG8_WAIT_L(0); PG8_BAR; PG8_MMA(1, 0, At, B0); PG8_MMA(1, 1, At, B1); PG8_BAR; PG8_SCHED;
            } else {
            PG8_LDB(B0, 0, 0); PG8_SCHED; PG8_LDA(At, 0, 0); PG8_STAGE(PG8_SA(1, 1), a1 + hstep, voffA);
            PG8_WAIT_L(8); PG8_BAR; PG8_WAIT_L(0); PG8_MMA(0, 0, At, B0); PG8_BAR; PG8_SCHED;
            PG8_LDB(B1, 0, 1); PG8_STAGE(PG8_SB(0, 0), b2, voffB);
            PG8_BAR; PG8_WAIT_L(0); PG8_MMA(0, 1, At, B1); PG8_BAR;
            PG8_LDA(At, 0, 1); PG8_STAGE(PG8_SA(0, 0), a2, voffA);
            PG8_BAR; PG8_WAIT_L(0); PG8_MMA(1, 0, At, B0); PG8_BAR; PG8_SCHED;
            PG8_STAGE(PG8_SB(0, 1), b2 + hstep, voffB);
            PG8_WAIT_V(6); PG8_BAR; PG8_MMA(1, 1, At, B1); PG8_BAR;
            PG8_LDB(B0, 1, 0); PG8_SCHED; PG8_LDA(At, 1, 0); PG8_STAGE(PG8_SA(0, 1), a2 + hstep, voffA);
            PG8_WAIT_L(8); PG8_BAR; PG8_WAIT_L(0); PG8_MMA(0, 0, At, B0); PG8_BAR; PG8_SCHED;
            PG8_LDB(B1, 1, 1); PG8_STAGE(PG8_SB(1, 0), b3, voffB);
            PG8_BAR; PG8_WAIT_L(0); PG8_MMA(0, 1, At, B1); PG8_BAR;
            PG8_LDA(At, 1, 1); PG8_STAGE(PG8_SA(1, 0), a3, voffA);
            PG8_BAR; PG8_WAIT_L(0); PG8_MMA(1, 0, At, B0); PG8_BAR; PG8_SCHED;
            PG8_STAGE(PG8_SB(1, 1), b3 + hstep, voffB);
            PG8_WAIT_V(6); PG8_BAR; PG8_MMA(1, 1, At, B1); PG8_BAR;
            }
        }
        if constexpr (ALIGN_EPI) { if (wr == 0) PG8_BAR; }
        if constexpr (!Epi::AFTER_DRAIN) { E(acc, cur, wr, wc, fr, fq); S.done(cur); }
        if (!has_next) break;
#pragma unroll
        for (int a = 0; a < 2; ++a)
#pragma unroll
            for (int b = 0; b < 2; ++b)
#pragma unroll
                for (int m = 0; m < 4; ++m)
#pragma unroll
                    for (int n = 0; n < 2; ++n) acc[a][b][m][n] = (f32x4){0.f, 0.f, 0.f, 0.f};
        cur = nxt; cA = nA; cB = nB; ++ui;
        if constexpr (ALIGN_EPI) { if (wr == 1) PG8_BAR; }
    }
    PG8_WAIT_V(0);
    if constexpr (!ALIGN_EPI) { if (wr == 0) PG8_BAR; }
    PG8_BAR;
    if constexpr (Epi::AFTER_DRAIN) { E.fused(acc, cur, wr, wc, fr, fq, lds, wid, lane); S.done(cur); }
#undef PG8_SA
#undef PG8_SB
#undef PG8_STAGE
#undef PG8_LDA
#undef PG8_LDB
#undef PG8_MMA
#undef PG8_WAIT_V
#undef PG8_WAIT_L
#undef PG8_BAR
#undef PG8_SCHED
}
}

#define LAS __attribute__((address_space(3)))
typedef unsigned short bf16;
typedef unsigned v4u __attribute__((ext_vector_type(4)));
typedef unsigned v2u __attribute__((ext_vector_type(2)));
typedef float f32x4 __attribute__((ext_vector_type(4)));
typedef float f32x16 __attribute__((ext_vector_type(16)));
typedef short bf16x8 __attribute__((ext_vector_type(8)));
typedef __bf16 bf16x2_t __attribute__((ext_vector_type(2)));
typedef float f32x2_t __attribute__((ext_vector_type(2)));

constexpr int D = 2048, TP = 8192, NSMP = 128, MV = TP + NSMP, MP = 8448;
constexpr int SEQ = 2048, NB = 4;
constexpr int N1 = 12352, N1P = 12544;
constexpr int E = 4096;
constexpr int NZ = 8192;
constexpr int OFF_B = 12288, OFF_A = 12320;
constexpr int LDS_BYTES = 147456;
constexpr float RMS_EPS = 1e-6f;

constexpr size_t MiB = 1u << 20;
constexpr size_t WS_CTL = 0;
constexpr size_t WS_WT1 = 1 * MiB, WS_WT2 = 50 * MiB, WS_WT3 = 66 * MiB, WS_WT4 = 98 * MiB, WS_WT5 = 130 * MiB;
constexpr size_t WS_AR = 146 * MiB, WS_AI = WS_AR + 65536, WS_GL = WS_AI + 65536, WS_BBT = 147 * MiB, WS_CMT = 148 * MiB;
constexpr size_t WS_H = 149 * MiB;
constexpr size_t WS_P1 = 182 * MiB;
constexpr size_t WS_UZ = WS_P1;
constexpr size_t WS_REC = 385 * MiB;
constexpr size_t WS_YG = WS_REC, WS_Y2 = WS_REC + 66 * MiB;
constexpr size_t WS_OG = 673 * MiB;
constexpr size_t WS_X1 = 739 * MiB;
constexpr size_t WS_END = 805 * MiB;
constexpr int REC_BYTES = 73728, REC_WN = 0, REC_QD = 16384, REC_AT = 32768, REC_KDT = 40960, REC_UT = 57344;

constexpr size_t O_YP = 0, O_YS = 16777216, O_CONVP = O_YS + 262144, O_DELTAP = O_CONVP + 98304, O_REP = O_DELTAP + 2097152, O_IMP = O_REP + 65536,
                 O_CONVS = O_IMP + 65536, O_DELTAS = O_CONVS + 3145728, O_RES = O_DELTAS + 67108864, O_IMS = O_RES + 2097152, O_END = O_IMS + 2097152;

__device__ __forceinline__ float bf2f(unsigned short u) { return __uint_as_float((unsigned)u << 16); }
__device__ __forceinline__ unsigned pk2(float lo, float hi) { f32x2_t v = {lo, hi}; bf16x2_t b = __builtin_convertvector(v, bf16x2_t); return __builtin_bit_cast(unsigned, b); }
__device__ __forceinline__ unsigned short f2bf(float f) { return (unsigned short)(pk2(f, 0.f) & 0xffffu); }
__device__ __forceinline__ float lo_bf(unsigned u) { return __uint_as_float(u << 16); }
__device__ __forceinline__ float hi_bf(unsigned u) { return __uint_as_float(u & 0xffff0000u); }
__device__ __forceinline__ float wave_sum(float v) {
#pragma unroll
    for (int o = 1; o < 64; o <<= 1) v += __shfl_xor(v, o);
    return v;
}
__device__ __forceinline__ float sigmoidf_(float x) { return __builtin_amdgcn_rcpf(1.f + __expf(-x)); }
__device__ __forceinline__ float siluf_(float x) { return x * __builtin_amdgcn_rcpf(1.f + __expf(-x)); }
__device__ __forceinline__ float gelu_tanh(float x) {
    const float u = 0.7978845608028654f * (x + 0.044715f * x * x * x);
    const float t = 1.f - 2.f * __builtin_amdgcn_rcpf(1.f + __expf(2.f * u));
    return 0.5f * x * (1.f + t);
}
#define LDS_WAIT() asm volatile("s_waitcnt lgkmcnt(0)" ::: "memory")
#define MFMA32(a, b, c) __builtin_amdgcn_mfma_f32_32x32x16_bf16((a), (b), (c), 0, 0, 0)
#define BAR_LDS() do { asm volatile("s_waitcnt lgkmcnt(0)" ::: "memory"); __builtin_amdgcn_s_barrier(); asm volatile("" ::: "memory"); } while (0)
__device__ __forceinline__ int fresh_tid() { int t = threadIdx.x; asm volatile("" : "+v"(t)); return t; }

struct Args { const float* in[27]; float* out; unsigned char* ws; int ph_lo, ph_hi, flags, pad; };
struct Ctx {
    const Args& a;
#define CIN(name, k) __device__ __forceinline__ const float* name() const { return a.in[k]; }
    CIN(xp, 0) CIN(xs, 1) CIN(cs, 2) CIN(ds, 3) CIN(sre, 4) CIN(sim, 5) CIN(ng, 6) CIN(wing, 7) CIN(convw, 8) CIN(alog, 9) CIN(dtb, 10) CIN(onorm, 11) CIN(woutg, 12) CIN(nssm, 13)
    CIN(wins, 14) CIN(lre, 15) CIN(lim, 16) CIN(bre, 17) CIN(bim, 18) CIN(cre, 19) CIN(cim, 20) CIN(dssm, 21) CIN(logdt, 22) CIN(wglu, 23) CIN(bglu, 24) CIN(wouts, 25) CIN(nfin, 26)
#undef CIN
    __device__ __forceinline__ float* out() const { return a.out; }
#define CWS(type, name, off) __device__ __forceinline__ type* name() const { return (type*)(a.ws + (off)); }
    CWS(bf16, WT1, WS_WT1) CWS(bf16, WT2, WS_WT2) CWS(bf16, WT3, WS_WT3) CWS(bf16, WT4, WS_WT4) CWS(bf16, WT5, WS_WT5) CWS(bf16, H, WS_H) CWS(bf16, P1, WS_P1) CWS(bf16, OG, WS_OG)
    CWS(bf16, UZ, WS_UZ) CWS(bf16, YG, WS_YG) CWS(bf16, Y2, WS_Y2) CWS(bf16, BBT, WS_BBT) CWS(bf16, CMT, WS_CMT) CWS(float, X1, WS_X1) CWS(float, AR, WS_AR) CWS(float, AI, WS_AI)
    CWS(float, GL, WS_GL) CWS(unsigned char, REC, WS_REC) CWS(unsigned, ctl, WS_CTL)
#undef CWS
};

struct EpiStore {
    static constexpr bool PERM = true, AFTER_DRAIN = false;
    bf16* O; int ldc;
    __device__ __forceinline__ void operator()(const pg8::f32x4 (&acc)[2][2][4][2], const pg8::Unit& u, int wr, int wc, int fr, int fq) const {
        const int row0 = u.pm * 256 + wr * 64 + fr, col0 = u.pn * 256 + wc * 32 + 8 * fq;
#pragma unroll
        for (int ai = 0; ai < 2; ++ai)
#pragma unroll
            for (int m = 0; m < 4; ++m) { bf16* rowp = O + (size_t)(row0 + ai * 128 + m * 16) * ldc + col0;
#pragma unroll
                for (int bj = 0; bj < 2; ++bj) { const pg8::f32x4 v0 = acc[ai][bj][m][0], v1 = acc[ai][bj][m][1];
                    v4u w; w.x = pk2(v0[0], v0[1]); w.y = pk2(v0[2], v0[3]); w.z = pk2(v1[0], v1[1]); w.w = pk2(v1[2], v1[3]);
                    *(v4u*)(rowp + bj * 128) = w; } }
    }
};
struct EpiResid {
    static constexpr bool PERM = true, AFTER_DRAIN = false;
    const float* xp; const float* xs; float* X1;
    __device__ __forceinline__ void operator()(const pg8::f32x4 (&acc)[2][2][4][2], const pg8::Unit& u, int wr, int wc, int fr, int fq) const {
        const int row0 = u.pm * 256 + wr * 64 + fr, col0 = u.pn * 256 + wc * 32 + 8 * fq;
#pragma unroll
        for (int ai = 0; ai < 2; ++ai)
#pragma unroll
            for (int m = 0; m < 4; ++m) { const int r = row0 + ai * 128 + m * 16;
                if (r < MV) { const float* xr = (r < TP ? xp + (size_t)r * D : xs + (size_t)(r - TP) * D) + col0; float* orow = X1 + (size_t)r * D + col0;
#pragma unroll
                    for (int bj = 0; bj < 2; ++bj) { const f32x4 a0 = __builtin_nontemporal_load((const f32x4*)(xr + bj * 128)), a1 = __builtin_nontemporal_load((const f32x4*)(xr + bj * 128 + 4));
                        *(f32x4*)(orow + bj * 128) = a0 + acc[ai][bj][m][0]; *(f32x4*)(orow + bj * 128 + 4) = a1 + acc[ai][bj][m][1]; } } }
    }
};
struct EpiResid2 {
    static constexpr bool PERM = true, AFTER_DRAIN = false;
    float* X1;
    __device__ __forceinline__ void operator()(const pg8::f32x4 (&acc)[2][2][4][2], const pg8::Unit& u, int wr, int wc, int fr, int fq) const {
        const int row0 = u.pm * 256 + wr * 64 + fr, col0 = u.pn * 256 + wc * 32 + 8 * fq;
#pragma unroll
        for (int ai = 0; ai < 2; ++ai)
#pragma unroll
            for (int m = 0; m < 4; ++m) { const int r = row0 + ai * 128 + m * 16;
                if (r < MV) { float* orow = X1 + (size_t)r * D + col0;
#pragma unroll
                    for (int bj = 0; bj < 2; ++bj) { const f32x4 a0 = *(const f32x4*)(orow + bj * 128), a1 = *(const f32x4*)(orow + bj * 128 + 4);
                        *(f32x4*)(orow + bj * 128) = a0 + acc[ai][bj][m][0]; *(f32x4*)(orow + bj * 128 + 4) = a1 + acc[ai][bj][m][1]; } } }
    }
};
struct EpiGlu {
    static constexpr bool PERM = true, AFTER_DRAIN = false;
    const bf16* YG; const bf16* UZ; const float* bglu; bf16* Y2;
    __device__ __forceinline__ void operator()(const pg8::f32x4 (&acc)[2][2][4][2], const pg8::Unit& u, int wr, int wc, int fr, int fq) const {
        const int row0 = u.pm * 256 + wr * 64 + fr, col0 = u.pn * 256 + wc * 32 + 8 * fq;
#pragma unroll
        for (int bj = 0; bj < 2; ++bj) { const int c = col0 + bj * 128; const f32x4 b0 = *(const f32x4*)(bglu + c), b1 = *(const f32x4*)(bglu + c + 4);
#pragma unroll
            for (int ai = 0; ai < 2; ++ai)
#pragma unroll
                for (int m = 0; m < 4; ++m) { const size_t r = (size_t)(row0 + ai * 128 + m * 16);
                    const v4u yv = *(const v4u*)(YG + r * E + c), zv = __builtin_nontemporal_load((const v4u*)(UZ + r * NZ + E + c));
                    const f32x4 g0 = acc[ai][bj][m][0] + b0, g1 = acc[ai][bj][m][1] + b1;
                    float o[8];
                    o[0] = lo_bf(yv.x) * sigmoidf_(g0[0]) * siluf_(lo_bf(zv.x)); o[1] = hi_bf(yv.x) * sigmoidf_(g0[1]) * siluf_(hi_bf(zv.x));
                    o[2] = lo_bf(yv.y) * sigmoidf_(g0[2]) * siluf_(lo_bf(zv.y)); o[3] = hi_bf(yv.y) * sigmoidf_(g0[3]) * siluf_(hi_bf(zv.y));
                    o[4] = lo_bf(yv.z) * sigmoidf_(g1[0]) * siluf_(lo_bf(zv.z)); o[5] = hi_bf(yv.z) * sigmoidf_(g1[1]) * siluf_(hi_bf(zv.z));
                    o[6] = lo_bf(yv.w) * sigmoidf_(g1[2]) * siluf_(lo_bf(zv.w)); o[7] = hi_bf(yv.w) * sigmoidf_(g1[3]) * siluf_(hi_bf(zv.w));
                    v4u w; w.x = pk2(o[0], o[1]); w.y = pk2(o[2], o[3]); w.z = pk2(o[4], o[5]); w.w = pk2(o[6], o[7]);
                    *(v4u*)(Y2 + r * E + c) = w; } }
    }
};

template <bool NTS = false>
__device__ __forceinline__ void p0_transpose_item(const float* W, int K, int N, bf16* WT, LAS float* scr, int item, int lane) {
    const int nblk = N / 32, kb = item / nblk, nb = item % nblk, k0 = 64 * kb, n0 = 32 * nb;
#pragma unroll 8
    for (int i = 0; i < 32; ++i) { const int kk = 2 * i + (lane >> 5); scr[kk * 33 + (lane & 31)] = __builtin_nontemporal_load(W + (size_t)(k0 + kk) * N + n0 + (lane & 31)); }
    LDS_WAIT(); asm volatile("" ::: "memory");
    const int c = lane & 7;
#pragma unroll
    for (int j = 0; j < 4; ++j) { const int n = (lane >> 3) + 8 * j; const LAS float* s = scr + (8 * c) * 33 + n;
        v4u o; o.x = pk2(s[0 * 33], s[1 * 33]); o.y = pk2(s[2 * 33], s[3 * 33]); o.z = pk2(s[4 * 33], s[5 * 33]); o.w = pk2(s[6 * 33], s[7 * 33]);
        if (NTS) __builtin_nontemporal_store(o, (v4u*)(WT + (size_t)(n0 + n) * K + k0 + 8 * c)); else *(v4u*)(WT + (size_t)(n0 + n) * K + k0 + 8 * c) = o; }
    LDS_WAIT(); asm volatile("" ::: "memory");
}
template <bool NT = false>
__device__ __forceinline__ void rms_row_bf16(const float* xrow, const float* g, bf16* orow, int lane) {
    const f32x4* xr = (const f32x4*)xrow + lane; f32x4 v[8]; float s = 0.f;
#pragma unroll
    for (int j = 0; j < 8; ++j) { v[j] = NT ? __builtin_nontemporal_load(xr + 64 * j) : xr[64 * j]; s += (v[j].x * v[j].x + v[j].y * v[j].y) + (v[j].z * v[j].z + v[j].w * v[j].w); }
    const float rs = 1.f / sqrtf(wave_sum(s) * (1.f / D) + RMS_EPS);
    const f32x4* gr = (const f32x4*)g + lane; v2u* o8 = (v2u*)orow + lane;
#pragma unroll
    for (int j = 0; j < 8; ++j) { const f32x4 gv = gr[64 * j]; v2u o; o.x = pk2(v[j].x * rs * gv.x, v[j].y * rs * gv.y); o.y = pk2(v[j].z * rs * gv.z, v[j].w * rs * gv.w); o8[64 * j] = o; }
}
__device__ __forceinline__ void rms_row_f32(const float* xrow, const float* g, float* orow, int lane) {
    const f32x4* xr = (const f32x4*)xrow + lane; f32x4 v[8]; float s = 0.f;
#pragma unroll
    for (int j = 0; j < 8; ++j) { v[j] = __builtin_nontemporal_load(xr + 64 * j); s += (v[j].x * v[j].x + v[j].y * v[j].y) + (v[j].z * v[j].z + v[j].w * v[j].w); }
    const float rs = 1.f / sqrtf(wave_sum(s) * (1.f / D) + RMS_EPS);
    const f32x4* gr = (const f32x4*)g + lane; f32x4* o = (f32x4*)orow + lane;
#pragma unroll
    for (int j = 0; j < 8; ++j) { const f32x4 gv = gr[64 * j]; __builtin_nontemporal_store(v[j] * rs * gv, o + 64 * j); }
}
__device__ __forceinline__ void phase0(const Ctx& C, LAS unsigned char* lds) {
    const int tid = fresh_tid(), lane = tid & 63, wave = tid >> 6;
    const int gw = blockIdx.x * 8 + wave, NGW = gridDim.x * 8;
    LAS float* scr = (LAS float*)(lds + wave * 16384);
    constexpr int I1 = (D / 64) * (N1 / 32), I2 = (E / 64) * (D / 32), I3 = (D / 64) * (NZ / 32), I4 = (E / 64) * (E / 32), I5 = I2, NIT = I1 + I2 + I3 + I4 + I5;
    for (int it = gw; it < NIT; it += NGW) {
        int r = it;
        if (r < I1) { p0_transpose_item(C.wing(), D, N1, C.WT1(), scr, r, lane); continue; } r -= I1;
        if (r < I2) { p0_transpose_item<true>(C.woutg(), E, D, C.WT2(), scr, r, lane); continue; } r -= I2;
        if (r < I3) { p0_transpose_item<true>(C.wins(), D, NZ, C.WT3(), scr, r, lane); continue; } r -= I3;
        if (r < I4) { p0_transpose_item<true>(C.wglu(), E, E, C.WT4(), scr, r, lane); continue; } r -= I4;
        p0_transpose_item<true>(C.wouts(), E, D, C.WT5(), scr, r, lane);
    }
    const int gt = blockIdx.x * 512 + tid, NGT = gridDim.x * 512;
    {
        v4u* z = (v4u*)(C.WT1() + (size_t)N1 * D); const v4u zero = {0u, 0u, 0u, 0u};
        for (int i = gt; i < (N1P - N1) * D / 8; i += NGT) z[i] = zero;
    }
    for (int m = gw; m < MP; m += NGW) {
        if (m < MV) rms_row_bf16<true>(m < TP ? C.xp() + (size_t)m * D : C.xs() + (size_t)(m - TP) * D, C.ng(), C.H() + (size_t)m * D, lane);
        else { v4u* o = (v4u*)(C.H() + (size_t)m * D); const v4u zero = {0u, 0u, 0u, 0u};
#pragma unroll
            for (int j = 0; j < 4; ++j) o[lane + 64 * j] = zero; }
    }
    if (gt < 256 * 64) {
        const int g = gt >> 6, p = gt & 63;
        const float lr = fminf(C.lre()[gt], -1e-4f), li = C.lim()[gt], dt = expf(C.logdt()[g]);
        const float mag = expf(lr * dt), ar = mag * cosf(li * dt), ai = mag * sinf(li * dt);
        const float den = lr * lr + li * li, xr = ar - 1.f, fr = (xr * lr + ai * li) / den, fi = (ai * lr - xr * li) / den;
        C.AR()[gt] = ar; C.AI()[gt] = ai;
        const float* br = C.bre() + (size_t)gt * 16; const float* bi = C.bim() + (size_t)gt * 16;
        bf16* o_re = C.BBT() + ((size_t)g * 128 + p) * 16; bf16* o_im = C.BBT() + ((size_t)g * 128 + 64 + p) * 16;
#pragma unroll
        for (int c = 0; c < 16; ++c) { const float b_r = br[c], b_i = bi[c]; o_re[c] = f2bf(fr * b_r - fi * b_i); o_im[c] = f2bf(fr * b_i + fi * b_r); }
#pragma unroll
        for (int c = 0; c < 16; ++c) { const size_t ci = ((size_t)g * 16 + c) * 64 + p; bf16* cm = C.CMT() + ((size_t)g * 16 + c) * 128;
            *(unsigned*)(cm + 2 * p) = pk2(C.cre()[ci], -C.cim()[ci]); }
    }
    {
        const f32x4* src = (const f32x4*)C.xs(); f32x4* dst = (f32x4*)(C.X1() + (size_t)TP * D);
        for (int i = gt; i < NSMP * D / 4; i += NGT) dst[i] = src[i];
    }
    {
        const f32x4* src = (const f32x4*)C.cs(); f32x4* dst = (f32x4*)(C.out() + O_CONVS);
        for (int i = gt; i < NSMP * 2 * 2048; i += NGT) { const int b = i / 4096, rem = i % 4096, r = rem / 2048, c4 = rem % 2048;
            dst[((size_t)b * 3 + r) * 2048 + c4] = src[((size_t)b * 3 + r + 1) * 2048 + c4]; }
    }
}

template <int CB, int K, class F>
__device__ __forceinline__ void skinny_wave(const bf16* A, int lda, const bf16* Bt, int lane, int rot, F&& epi) {
    const int i16 = lane & 15, q4 = lane >> 4;
    const bf16* ap = A + (size_t)i16 * lda + 8 * q4;
    const bf16* bp = Bt + (size_t)i16 * K + 8 * q4;
    f32x4 acc[CB];
#pragma unroll
    for (int j = 0; j < CB; ++j) acc[j] = (f32x4){0.f, 0.f, 0.f, 0.f};
    constexpr int U = CB == 1 ? 8 : 4;
    constexpr int nst = K / (32 * U); const int kofs = (rot * 32 * U) & (K - 1);
    bf16x8 a[2][U], b[2][CB][U];
#define SK_ISSUE(buf, st) do { const int k_ = (((st) < nst ? (st) : nst - 1) * 32 * U + kofs) & (K - 1); _Pragma("unroll") for (int u = 0; u < U; ++u) { a[buf][u] = *(const bf16x8*)(ap + k_ + 32 * u); \
        _Pragma("unroll") for (int j = 0; j < CB; ++j) b[buf][j][u] = *(const bf16x8*)(bp + (size_t)(16 * j) * K + k_ + 32 * u); } } while (0)
#define SK_MMA(buf) do { _Pragma("unroll") for (int u = 0; u < U; ++u) _Pragma("unroll") for (int j = 0; j < CB; ++j) acc[j] = __builtin_amdgcn_mfma_f32_16x16x32_bf16(b[buf][j][u], a[buf][u], acc[j], 0, 0, 0); } while (0)
    SK_ISSUE(0, 0);
#pragma unroll
    for (int st = 0; st < nst; st += 2) {
        SK_ISSUE(1, st + 1); __builtin_amdgcn_sched_barrier(0); SK_MMA(0); __builtin_amdgcn_sched_barrier(0);
        SK_ISSUE(0, st + 2); __builtin_amdgcn_sched_barrier(0); SK_MMA(1); __builtin_amdgcn_sched_barrier(0);
    }
#undef SK_ISSUE
#undef SK_MMA
#pragma unroll
    for (int j = 0; j < CB; ++j) epi(j, acc[j]);
}
template <int CBT, int CBW, int K, int LDB, class F>
__device__ __forceinline__ void skinny_wg(const bf16* A, int lda, const bf16* Bt, LAS unsigned char* lds, int tid, int jb, int rot, F&& epi) {
    constexpr int U = 8, SK = 32 * U, nst = K / SK, BPITCH = 528, BUFB = CBT * 16 * BPITCH;
    const int lane = tid & 63, i16 = lane & 15, q4 = lane >> 4;
    const bf16* ap = A + (size_t)i16 * lda + 8 * q4;
    const bf16* bg = Bt + (size_t)(tid >> 5) * LDB + (tid & 31) * 8;
    const int bl = (tid >> 5) * BPITCH + (tid & 31) * 16, kofs = (rot * SK) & (K - 1);
    const LAS unsigned char* br = lds + (jb * 16 + i16) * BPITCH + 16 * q4;
    f32x4 acc[CBW];
#pragma unroll
    for (int j = 0; j < CBW; ++j) acc[j] = (f32x4){0.f, 0.f, 0.f, 0.f};
    bf16x8 a[2][U]; v4u breg[CBT];
#define SKG_LOAD(buf, st) do { const int k_ = (((st) < nst ? (st) : nst - 1) * SK + kofs) & (K - 1); \
        _Pragma("unroll") for (int j = 0; j < CBT; ++j) breg[j] = *(const v4u*)(bg + (size_t)(16 * j) * LDB + k_); \
        _Pragma("unroll") for (int u = 0; u < U; ++u) a[buf][u] = *(const bf16x8*)(ap + k_ + 32 * u); } while (0)
    SKG_LOAD(0, 0);
#pragma unroll
    for (int st = 0; st < nst; ++st) {
        const int cb = st & 1;
#pragma unroll
        for (int j = 0; j < CBT; ++j) *(LAS v4u*)(lds + cb * BUFB + j * 16 * BPITCH + bl) = breg[j];
        SKG_LOAD(cb ^ 1, st + 1);
        BAR_LDS();
#pragma unroll
        for (int u = 0; u < U; ++u)
#pragma unroll
            for (int j = 0; j < CBW; ++j) acc[j] = __builtin_amdgcn_mfma_f32_16x16x32_bf16(*(const LAS bf16x8*)(br + cb * BUFB + j * 16 * BPITCH + 64 * u), a[cb][u], acc[j], 0, 0, 0);
    }
#undef SKG_LOAD
#pragma unroll
    for (int j = 0; j < CBW; ++j) epi(j, acc[j]);
}
__device__ __forceinline__ v2u pk4(const f32x4 v) { v2u w; w.x = pk2(v[0], v[1]); w.y = pk2(v[2], v[3]); return w; }

__device__ __forceinline__ bf16x8 afrag(const LAS unsigned char* p) {
    const v2u lo = *(const LAS v2u*)p, hi = *(const LAS v2u*)(p + 16); const v4u r = {lo.x, lo.y, hi.x, hi.y}; return __builtin_bit_cast(bf16x8, r);
}
__device__ __forceinline__ bf16x8 pack_half(const f32x16& X, int sub) {
    v4u r; r.x = pk2(X[8 * sub], X[8 * sub + 1]); r.y = pk2(X[8 * sub + 2], X[8 * sub + 3]); r.z = pk2(X[8 * sub + 4], X[8 * sub + 5]); r.w = pk2(X[8 * sub + 6], X[8 * sub + 7]);
    return __builtin_bit_cast(bf16x8, r);
}
constexpr int PQ_QL = 0, PQ_KL = 17408, PQ_KT = 34816, PQ_VT = 53248, PQ_KK = 90112, PQ_QK = 107520, PQ_LS0 = 124928, PQ_MISC = 142336;
constexpr int QL_PITCH = 272, KT_PITCH = 144, TB_PITCH = 136, KK_PITCH = 68;
__device__ __forceinline__ void gdn_prep_load(const Ctx& C, int unit, int tid, unsigned (&raw)[35], unsigned (&rab)[2]) {
    const int n = unit & 31, hq = (unit >> 5) & 15, b = unit >> 9, tensor = tid >> 7, cp = tid & 63, rh = (tid >> 6) & 1, lane = tid & 63;
    const size_t m0 = (size_t)b * SEQ + (size_t)n * 64;
    const int cidx = (tensor == 0 ? hq * 128 : tensor == 1 ? 2048 + hq * 128 : 4096 + (2 * hq + tensor - 2) * 128) + 2 * cp;
    const bf16* pc = C.P1() + (m0 + rh * 32) * N1P + cidx;
    const bool halo = n > 0 || rh > 0;
#pragma unroll
    for (int i = 0; i < 3; ++i) raw[i] = halo ? *(const unsigned*)(pc - (3 - i) * (ptrdiff_t)N1P) : 0u;
#pragma unroll
    for (int i = 0; i < 32; ++i) raw[3 + i] = *(const unsigned*)(pc + (size_t)i * N1P);
    if (tid < 128) { const bf16* pr = C.P1() + (m0 + lane) * N1P; const int hvw = 2 * hq + (tid >> 6); rab[0] = pr[OFF_A + hvw]; rab[1] = pr[OFF_B + hvw]; }
}
__device__ __forceinline__ void gdn_prep_unit(const Ctx& C, LAS unsigned char* lds, int unit, int next_unit, int tid_in, unsigned (&raw)[35], unsigned (&rab)[2]) {
    int tid = tid_in; asm volatile("" : "+v"(tid));
    const int lane = tid & 63, wave = __builtin_amdgcn_readfirstlane(tid >> 6);
    const int n = unit & 31, hq = (unit >> 5) & 15, b = unit >> 9;
    const int tensor = tid >> 7, ch = tid & 127;
    const size_t m0 = (size_t)b * SEQ + (size_t)n * 64;
    LAS float* KKs = (LAS float*)(lds + PQ_KK); LAS float* QKs = (LAS float*)(lds + PQ_QK); LAS float* Ls0 = (LAS float*)(lds + PQ_LS0);
    LAS float* gcS = (LAS float*)(lds + PQ_MISC); LAS float* betaS = gcS + 128; LAS float* rnq = gcS + 256; LAS float* rnk = gcS + 320;
    LAS float* f1 = gcS + 384;
    if (wave < 2) {
        const int hvw = 2 * hq + wave;
        const float av = bf2f((unsigned short)rab[0]), bv = bf2f((unsigned short)rab[1]);
        const float xx = av + C.dtb()[hvw]; const float sp = xx > 20.f ? xx : log1pf(__expf(xx));
        float g = -__expf(C.alog()[hvw]) * sp;
#pragma unroll
        for (int o = 1; o < 64; o <<= 1) { const float t = __shfl_up(g, o); if (lane >= o) g += t; }
        gcS[wave * 64 + lane] = g; betaS[wave * 64 + lane] = sigmoidf_(bv);
    }
    const int cp = tid & 63, rh = (tid >> 6) & 1;
    float xa[32], xb[32];
    {
        const int cidx = (tensor == 0 ? hq * 128 : tensor == 1 ? 2048 + hq * 128 : 4096 + (2 * hq + tensor - 2) * 128) + 2 * cp;
        const float* cw = C.convw() + cidx;
        const f32x2_t w0 = *(const f32x2_t*)cw, w1 = *(const f32x2_t*)(cw + 8192), w2 = *(const f32x2_t*)(cw + 2 * 8192), w3 = *(const f32x2_t*)(cw + 3 * 8192);
        const unsigned p3 = raw[0], p2 = raw[1], p1 = raw[2];
        float a3 = lo_bf(p3), a2 = lo_bf(p2), a1 = lo_bf(p1), b3 = hi_bf(p3), b2 = hi_bf(p2), b1 = hi_bf(p1);
#pragma unroll
        for (int i = 0; i < 32; ++i) { const unsigned pv = raw[3 + i]; const float ai = lo_bf(pv), bi = hi_bf(pv);
            xa[i] = siluf_(w0.x * a3 + w1.x * a2 + w2.x * a1 + w3.x * ai); xb[i] = siluf_(w0.y * b3 + w1.y * b2 + w2.y * b1 + w3.y * bi);
            a3 = a2; a2 = a1; a1 = ai; b3 = b2; b2 = b1; b1 = bi; }
        if (tensor < 2) {
            LAS unsigned* dst = (LAS unsigned*)(lds + (tensor ? PQ_KL : PQ_QL) + (rh * 32) * QL_PITCH) + cp;
#pragma unroll
            for (int i = 0; i < 32; ++i) dst[i * (QL_PITCH / 4)] = pk2(xa[i], xb[i]);
            if (tensor == 1) { LAS v4u* kta = (LAS v4u*)(lds + PQ_KT + (2 * cp) * KT_PITCH + rh * 64); LAS v4u* ktb = (LAS v4u*)(lds + PQ_KT + (2 * cp + 1) * KT_PITCH + rh * 64);
#pragma unroll
                for (int q = 0; q < 4; ++q) { v4u w; w.x = pk2(xa[8 * q], xa[8 * q + 1]); w.y = pk2(xa[8 * q + 2], xa[8 * q + 3]); w.z = pk2(xa[8 * q + 4], xa[8 * q + 5]); w.w = pk2(xa[8 * q + 6], xa[8 * q + 7]); kta[q] = w;
                    v4u u; u.x = pk2(xb[8 * q], xb[8 * q + 1]); u.y = pk2(xb[8 * q + 2], xb[8 * q + 3]); u.z = pk2(xb[8 * q + 4], xb[8 * q + 5]); u.w = pk2(xb[8 * q + 6], xb[8 * q + 7]); ktb[q] = u; } }
        }
    }
    BAR_LDS();
    if (tensor >= 2) {
        const int e = tensor - 2; const LAS float* be = betaS + e * 64 + rh * 32;
        LAS v4u* vta = (LAS v4u*)(lds + PQ_VT + (e * 128 + 2 * cp) * KT_PITCH + rh * 64); LAS v4u* vtb = (LAS v4u*)(lds + PQ_VT + (e * 128 + 2 * cp + 1) * KT_PITCH + rh * 64);
#pragma unroll
        for (int q = 0; q < 4; ++q) { v4u w; w.x = pk2(xa[8 * q] * be[8 * q], xa[8 * q + 1] * be[8 * q + 1]); w.y = pk2(xa[8 * q + 2] * be[8 * q + 2], xa[8 * q + 3] * be[8 * q + 3]);
            w.z = pk2(xa[8 * q + 4] * be[8 * q + 4], xa[8 * q + 5] * be[8 * q + 5]); w.w = pk2(xa[8 * q + 6] * be[8 * q + 6], xa[8 * q + 7] * be[8 * q + 7]); vta[q] = w;
            v4u u; u.x = pk2(xb[8 * q] * be[8 * q], xb[8 * q + 1] * be[8 * q + 1]); u.y = pk2(xb[8 * q + 2] * be[8 * q + 2], xb[8 * q + 3] * be[8 * q + 3]);
            u.z = pk2(xb[8 * q + 4] * be[8 * q + 4], xb[8 * q + 5] * be[8 * q + 5]); u.w = pk2(xb[8 * q + 6] * be[8 * q + 6], xb[8 * q + 7] * be[8 * q + 7]); vtb[q] = u; }
    }
    {
        const int mat = wave >> 2, ti = (wave >> 1) & 1, tj = wave & 1, c32 = lane & 31, h = lane >> 5;
        const LAS unsigned char* Ab = lds + (mat ? PQ_QL : PQ_KL) + (32 * ti + c32) * QL_PITCH + h * 16;
        const LAS unsigned char* Bb = lds + PQ_KL + (32 * tj + c32) * QL_PITCH + h * 16;
        f32x16 acc;
#pragma unroll
        for (int r = 0; r < 16; ++r) acc[r] = 0.f;
#pragma unroll
        for (int s = 0; s < 8; ++s) { const bf16x8 a = *(const LAS bf16x8*)(Ab + s * 32), bb = *(const LAS bf16x8*)(Bb + s * 32); acc = MFMA32(a, bb, acc); }
        LAS float* Ot = mat ? QKs : KKs;
#pragma unroll
        for (int r = 0; r < 16; ++r) { const int row = 32 * ti + (r & 3) + 8 * (r >> 2) + 4 * h; Ot[row * KK_PITCH + 32 * tj + c32] = acc[r]; }
        if (mat == 0 && ti == tj) {
#pragma unroll
            for (int r = 0; r < 16; ++r) if (((r & 3) + 8 * (r >> 2) + 4 * h) == c32) rnk[32 * ti + c32] = 1.f / sqrtf(acc[r] + 1e-6f);
        }
        if (wave < 2) {
            const LAS unsigned char* Qb = lds + PQ_QL + (32 * wave + c32) * QL_PITCH + h * 16;
            f32x16 qq;
#pragma unroll
            for (int r = 0; r < 16; ++r) qq[r] = 0.f;
#pragma unroll
            for (int s = 0; s < 8; ++s) { const bf16x8 a = *(const LAS bf16x8*)(Qb + s * 32); qq = MFMA32(a, a, qq); }
#pragma unroll
            for (int r = 0; r < 16; ++r) if (((r & 3) + 8 * (r >> 2) + 4 * h) == c32) rnq[32 * wave + c32] = 0.08838834764831845f / sqrtf(qq[r] + 1e-6f);
        }
    }
    BAR_LDS();
    if (tid < 128) { const int e = tid >> 6, i = tid & 63; const float gc = gcS[tid], gl = gcS[e * 64 + 63], eg = __expf(gc);
        f1[tid] = rnq[i] * eg; f1[128 + tid] = rnk[i] * __expf(gl - gc); f1[256 + tid] = betaS[tid] * rnk[i] * eg; }
    BAR_LDS();
    const LAS float* f2 = f1 + 128; const LAS float* f3 = f1 + 256;
    {
        unsigned char* rec0 = C.REC() + (size_t)((b * 32 + 2 * hq) * 32 + n) * REC_BYTES;
#pragma unroll
        for (int r = 0; r < 2; ++r) { const int it = tid + 512 * r, i = it >> 4, j0 = (it & 15) * 4;
            const f32x4 kk4 = *(const LAS f32x4*)(KKs + i * KK_PITCH + j0), qk4 = *(const LAS f32x4*)(QKs + i * KK_PITCH + j0);
            const float rki = rnk[i], rqi = rnq[i], g0i = gcS[i], g1i = gcS[64 + i], b0i = betaS[i], b1i = betaS[64 + i];
            f32x4 l0, l1; float a0[4], a1[4];
#pragma unroll
            for (int t = 0; t < 4; ++t) { const int j = j0 + t; const float rkj = rnk[j];
                const float kk = kk4[t] * rki * rkj, qk = qk4[t] * rqi * rkj, d0 = __expf(g0i - gcS[j]), d1 = __expf(g1i - gcS[64 + j]);
                l0[t] = j < i ? b0i * kk * d0 : 0.f; l1[t] = j < i ? b1i * kk * d1 : 0.f; a0[t] = j <= i ? qk * d0 : 0.f; a1[t] = j <= i ? qk * d1 : 0.f; }
            *(LAS f32x4*)(Ls0 + i * KK_PITCH + j0) = l0; *(LAS f32x4*)(KKs + i * KK_PITCH + j0) = l1;
            v2u w0; w0.x = pk2(a0[0], a0[1]); w0.y = pk2(a0[2], a0[3]); v2u w1; w1.x = pk2(a1[0], a1[1]); w1.y = pk2(a1[2], a1[3]);
            *(v2u*)(rec0 + REC_AT + (i * 64 + j0) * 2) = w0; *(v2u*)(rec0 + (size_t)32 * REC_BYTES + REC_AT + (i * 64 + j0) * 2) = w1; }
#pragma unroll
        for (int r = 0; r < 4; ++r) { const int it = tid + 512 * r, e = it >> 10, rem = it & 1023, i = rem >> 4, d8 = rem & 15;
            const v4u qv = *(const LAS v4u*)(lds + PQ_QL + i * QL_PITCH + d8 * 16); const float sc = f1[e * 64 + i];
            v4u w; w.x = pk2(lo_bf(qv.x) * sc, hi_bf(qv.x) * sc); w.y = pk2(lo_bf(qv.y) * sc, hi_bf(qv.y) * sc); w.z = pk2(lo_bf(qv.z) * sc, hi_bf(qv.z) * sc); w.w = pk2(lo_bf(qv.w) * sc, hi_bf(qv.w) * sc);
            *(v4u*)(rec0 + (size_t)e * 32 * REC_BYTES + REC_QD + i * 256 + d8 * 16) = w; }
#pragma unroll
        for (int r = 0; r < 4; ++r) { const int it = tid + 512 * r, e = it >> 10, rem = it & 1023, d = rem >> 3, i8 = rem & 7;
            const v4u kv = *(const LAS v4u*)(lds + PQ_KT + d * KT_PITCH + i8 * 16); const LAS float* sc = f2 + e * 64 + 8 * i8;
            v4u w; w.x = pk2(lo_bf(kv.x) * sc[0], hi_bf(kv.x) * sc[1]); w.y = pk2(lo_bf(kv.y) * sc[2], hi_bf(kv.y) * sc[3]); w.z = pk2(lo_bf(kv.z) * sc[4], hi_bf(kv.z) * sc[5]); w.w = pk2(lo_bf(kv.w) * sc[6], hi_bf(kv.w) * sc[7]);
            *(v4u*)(rec0 + (size_t)e * 32 * REC_BYTES + REC_KDT + d * 128 + i8 * 16) = w; }
        if (tid < 2) C.GL()[(b * 32 + 2 * hq + tid) * 32 + n] = __expf(gcS[tid * 64 + 63]);
    }
    BAR_LDS();
    if (next_unit >= 0) gdn_prep_load(C, next_unit, tid, raw, rab);
    if (wave < 2) {
        const int c32 = lane & 31, hb = lane >> 5;
        const LAS float* Lm = wave ? KKs : Ls0;
        const LAS float* L = Lm + (hb * 32) * KK_PITCH + hb * 32;
        float t[32];
#pragma unroll
        for (int i = 0; i < 32; ++i) {
            float s0 = (i == c32) ? 1.f : 0.f, s1 = 0.f, s2 = 0.f, s3 = 0.f;
#pragma unroll
            for (int j4 = 0; j4 < (i + 3) / 4; ++j4) { const f32x4 l = *(const LAS f32x4*)(L + i * KK_PITCH + 4 * j4);
                if (4 * j4 + 0 < i) s0 -= l.x * t[4 * j4 + 0];
                if (4 * j4 + 1 < i) s1 -= l.y * t[4 * j4 + 1];
                if (4 * j4 + 2 < i) s2 -= l.z * t[4 * j4 + 2];
                if (4 * j4 + 3 < i) s3 -= l.w * t[4 * j4 + 3]; }
            t[i] = (s0 + s1) + (s2 + s3);
        }
        const float sc = f3[wave * 64 + lane];
        LAS unsigned char* T1base = lds + PQ_QL + wave * 8704; LAS unsigned char* T2base = lds + PQ_QK + wave * 8704;
        {
            LAS bf16* T1 = (LAS bf16*)(T1base + (hb * 32) * TB_PITCH) + lane; LAS bf16* T2 = (LAS bf16*)(T2base + (hb * 32) * TB_PITCH) + lane;
#pragma unroll
            for (int i = 0; i < 32; ++i) { T1[i * (TB_PITCH / 2)] = f2bf(t[i]); T2[i * (TB_PITCH / 2)] = f2bf(t[i] * sc); }
            if (hb) { LAS bf16* Z1 = (LAS bf16*)T1base + lane; LAS bf16* Z2 = (LAS bf16*)T2base + lane;
#pragma unroll
                for (int i = 0; i < 32; ++i) { Z1[i * (TB_PITCH / 2)] = 0; Z2[i * (TB_PITCH / 2)] = 0; } }
        }
        if (!hb) { LAS v4u* tt = (LAS v4u*)((LAS unsigned char*)Lm + c32 * (KK_PITCH * 4) + 128);
#pragma unroll
            for (int q = 0; q < 4; ++q) { v4u w; w.x = pk2(t[8 * q], t[8 * q + 1]); w.y = pk2(t[8 * q + 2], t[8 * q + 3]); w.z = pk2(t[8 * q + 4], t[8 * q + 5]); w.w = pk2(t[8 * q + 6], t[8 * q + 7]); tt[q] = w; } }
        f32x16 M;
#pragma unroll
        for (int r = 0; r < 16; ++r) M[r] = 0.f;
#pragma unroll
        for (int s2 = 0; s2 < 2; ++s2) {
            const LAS f32x4* lp = (const LAS f32x4*)(Lm + (32 + c32) * KK_PITCH + 16 * s2 + 8 * hb); const f32x4 la = lp[0], lb = lp[1];
            v4u av; av.x = pk2(la.x, la.y); av.y = pk2(la.z, la.w); av.z = pk2(lb.x, lb.y); av.w = pk2(lb.z, lb.w);
            const bf16x8 bv = *(const LAS bf16x8*)((const LAS unsigned char*)Lm + c32 * (KK_PITCH * 4) + 128 + (16 * s2 + 8 * hb) * 2);
            M = MFMA32(__builtin_bit_cast(bf16x8, av), bv, M); }
        f32x16 T21;
#pragma unroll
        for (int r = 0; r < 16; ++r) T21[r] = 0.f;
#pragma unroll
        for (int s2 = 0; s2 < 2; ++s2) T21 = MFMA32(afrag(T1base + (32 + c32) * TB_PITCH + (32 + 16 * s2 + 4 * hb) * 2), pack_half(M, s2), T21);
        {   const float sc21 = f3[wave * 64 + c32];
            LAS bf16* T1 = (LAS bf16*)(T1base + (32 + 4 * hb) * TB_PITCH) + c32; LAS bf16* T2 = (LAS bf16*)(T2base + (32 + 4 * hb) * TB_PITCH) + c32;
#pragma unroll
            for (int r = 0; r < 16; ++r) { const int ro = ((r & 3) + 8 * (r >> 2)) * (TB_PITCH / 2); T1[ro] = f2bf(-T21[r]); T2[ro] = f2bf(-T21[r] * sc21); } }
    }
    BAR_LDS();
    {
        const int e = wave >> 2, ct = wave & 3, c32 = lane & 31, h = lane >> 5;
        unsigned char* rec = C.REC() + (size_t)((b * 32 + 2 * hq + e) * 32 + n) * REC_BYTES;
        const LAS unsigned char* Bv = lds + PQ_VT + (e * 128 + 32 * ct + c32) * KT_PITCH + h * 16;
        const LAS unsigned char* Bk = lds + PQ_KT + (32 * ct + c32) * KT_PITCH + h * 16;
#pragma unroll
        for (int t = 0; t < 2; ++t) {
            const LAS unsigned char* A1 = lds + PQ_QL + e * 8704 + (32 * t + c32) * TB_PITCH + h * 16;
            const LAS unsigned char* A2 = lds + PQ_QK + e * 8704 + (32 * t + c32) * TB_PITCH + h * 16;
            f32x16 au, aw;
#pragma unroll
            for (int r = 0; r < 16; ++r) { au[r] = 0.f; aw[r] = 0.f; }
#pragma unroll
            for (int s = 0; s < 4; ++s) {
                const v2u a1l = *(const LAS v2u*)(A1 + s * 32), a1h = *(const LAS v2u*)(A1 + s * 32 + 8), a2l = *(const LAS v2u*)(A2 + s * 32), a2h = *(const LAS v2u*)(A2 + s * 32 + 8);
                const v4u a1 = {a1l.x, a1l.y, a1h.x, a1h.y}, a2 = {a2l.x, a2l.y, a2h.x, a2h.y};
                au = MFMA32(__builtin_bit_cast(bf16x8, a1), *(const LAS bf16x8*)(Bv + s * 32), au);
                aw = MFMA32(*(const LAS bf16x8*)(Bk + s * 32), __builtin_bit_cast(bf16x8, a2), aw); }
            unsigned char* ut = rec + REC_UT + (32 * ct + c32) * 128 + (32 * t + 4 * h) * 2;
#pragma unroll
            for (int g4 = 0; g4 < 4; ++g4) { v2u w; w.x = pk2(au[4 * g4], au[4 * g4 + 1]); w.y = pk2(au[4 * g4 + 2], au[4 * g4 + 3]); *(v2u*)(ut + 16 * g4) = w; }
            unsigned char* wn = rec + REC_WN + ((32 * t + c32) * 128 + 32 * ct + 4 * h) * 2;
#pragma unroll
            for (int g4 = 0; g4 < 4; ++g4) { v2u w; w.x = pk2(-aw[4 * g4], -aw[4 * g4 + 1]); w.y = pk2(-aw[4 * g4 + 2], -aw[4 * g4 + 3]); *(v2u*)(wn + 16 * g4) = w; }
        }
    }
    BAR_LDS();
}
__device__ __forceinline__ void phase2(const Ctx& C, LAS unsigned char* lds) {
    {   const int tid = fresh_tid(); unsigned raw[35], rab[2] = {0u, 0u};
        if ((int)blockIdx.x < NB * 16 * 32) gdn_prep_load(C, blockIdx.x, tid, raw, rab);
#pragma unroll 1
        for (int u = blockIdx.x; u < NB * 16 * 32; u += gridDim.x) { const int nu = u + (int)gridDim.x; gdn_prep_unit(C, lds, u, nu < NB * 16 * 32 ? nu : -1, tid, raw, rab); } }
    const int gt = blockIdx.x * 512 + fresh_tid(), NGT = gridDim.x * 512;
    for (int i = gt; i < (NB * 3 + NSMP) * 4096; i += NGT) { const int rr = i >> 12, c2 = i & 4095;
        size_t m; float* dst;
        if (rr < NB * 3) { const int b = rr / 3, r = rr % 3; m = (size_t)b * SEQ + SEQ - 3 + r; dst = C.out() + O_CONVP + (size_t)rr * 8192; }
        else { const int b = rr - NB * 3; m = TP + b; dst = C.out() + O_CONVS + ((size_t)b * 3 + 2) * 8192; }
        const unsigned v = *(const unsigned*)(C.P1() + m * N1P + 2 * c2);
        f32x2_t o = {lo_bf(v), hi_bf(v)}; *(f32x2_t*)(dst + 2 * c2) = o; }
}

constexpr int SC_SLOT = 62464, SC_WNQD = 0, SC_ATK = 34816, SC_OBUF = 2 * SC_SLOT, SC_PITCH_A = 272, SC_PITCH_B = 144;
__device__ __forceinline__ void gdn_scan_unit(const Ctx& C, LAS unsigned char* lds, int bh) {
    const int tid = fresh_tid(), lane = tid & 63, wave = __builtin_amdgcn_readfirstlane(tid >> 6), c32 = lane & 31, h = lane >> 5;
    const int b = bh >> 5, hv = bh & 31;
    const unsigned char* rec0 = C.REC() + (size_t)bh * 32 * REC_BYTES;
    f32x16 S[4];
#pragma unroll
    for (int T = 0; T < 4; ++T)
#pragma unroll
        for (int r = 0; r < 16; ++r) S[T][r] = 0.f;
    const int lt = tid & 255;
    const int ldA = SC_WNQD + (lt >> 4) * SC_PITCH_A + (lt & 15) * 16, ldB = SC_ATK + (lt >> 3) * SC_PITCH_B + (lt & 7) * 16;
    if (wave >= 4) {
#pragma unroll
        for (int r = 0; r < 14; ++r) { const v4u v = *(const v4u*)(rec0 + 16 * lt + 4096 * r);
            *(LAS v4u*)(lds + (r < 8 ? ldA + r * 16 * SC_PITCH_A : ldB + (r - 8) * 32 * SC_PITCH_B)) = v; } }
    BAR_LDS();
    for (int n = 0; n < 32; ++n) {
        const unsigned char* rec = rec0 + (size_t)n * REC_BYTES;
        const LAS unsigned char* slot = lds + (n & 1) * SC_SLOT;
        const int ntok = tid >> 3, nseg = tid & 7; const size_t nm = (size_t)b * SEQ + n * 64 + ntok;
        const v4u* zp = (const v4u*)(C.P1() + nm * N1P + NZ + hv * 128 + nseg * 16); const v4u z0 = zp[0], z1 = zp[1];
        if (wave >= 4) {
            if (n < 31) { const unsigned char* nrec = rec + REC_BYTES; LAS unsigned char* ns = lds + ((n + 1) & 1) * SC_SLOT;
                v4u v[14];
#pragma unroll
                for (int r = 0; r < 14; ++r) v[r] = *(const v4u*)(nrec + 16 * lt + 4096 * r);
#pragma unroll
                for (int r = 0; r < 14; ++r) *(LAS v4u*)(ns + (r < 8 ? ldA + r * 16 * SC_PITCH_A : ldB + (r - 8) * 32 * SC_PITCH_B)) = v[r]; }
        } else {
            __builtin_amdgcn_s_setprio(1);
            const int dv = 32 * wave + c32;
            f32x16 V[2], O[2];
            {
                const unsigned char* ut = rec + REC_UT + dv * 128 + h * 8;
#pragma unroll
                for (int t = 0; t < 2; ++t)
#pragma unroll
                    for (int g4 = 0; g4 < 4; ++g4) { const v2u w = *(const v2u*)(ut + (32 * t + 8 * g4) * 2);
                        V[t][4 * g4 + 0] = lo_bf(w.x); V[t][4 * g4 + 1] = hi_bf(w.x); V[t][4 * g4 + 2] = lo_bf(w.y); V[t][4 * g4 + 3] = hi_bf(w.y); }
#pragma unroll
                for (int t = 0; t < 2; ++t)
#pragma unroll
                    for (int r = 0; r < 16; ++r) O[t][r] = 0.f;
            }
            const float gl = C.GL()[bh * 32 + n];
            const LAS unsigned char* aW = slot + SC_WNQD + c32 * SC_PITCH_A + h * 8;
            const LAS unsigned char* aK = slot + SC_ATK + c32 * SC_PITCH_B + h * 8;
#pragma unroll
            for (int s = 0; s < 8; ++s) { const bf16x8 sb = pack_half(S[s >> 1], s & 1);
                V[0] = MFMA32(afrag(aW + s * 32), sb, V[0]);
                V[1] = MFMA32(afrag(aW + 32 * SC_PITCH_A + s * 32), sb, V[1]);
                O[0] = MFMA32(afrag(aW + 64 * SC_PITCH_A + s * 32), sb, O[0]);
                O[1] = MFMA32(afrag(aW + 96 * SC_PITCH_A + s * 32), sb, O[1]); __builtin_amdgcn_sched_barrier(0); }
#pragma unroll
            for (int T = 0; T < 4; ++T) S[T] = S[T] * gl;
#pragma unroll
            for (int s = 0; s < 4; ++s) { const bf16x8 vb = pack_half(V[s >> 1], s & 1);
                O[0] = MFMA32(afrag(aK + s * 32), vb, O[0]);
                O[1] = MFMA32(afrag(aK + 32 * SC_PITCH_B + s * 32), vb, O[1]);
#pragma unroll
                for (int T = 0; T < 4; ++T) S[T] = MFMA32(afrag(aK + (64 + 32 * T) * SC_PITCH_B + s * 32), vb, S[T]);
                __builtin_amdgcn_sched_barrier(0); }
            LAS bf16* ob = (LAS bf16*)(lds + SC_OBUF) + dv;
#pragma unroll
            for (int t = 0; t < 2; ++t)
#pragma unroll
                for (int r = 0; r < 16; ++r) { const int tok = 32 * t + (r & 3) + 8 * (r >> 2) + 4 * h; ob[tok * (SC_PITCH_A / 2)] = f2bf(O[t][r]); }
            __builtin_amdgcn_s_setprio(0);
        }
        BAR_LDS();
        {
            const int tok = ntok, seg = nseg; const size_t m = nm;
            const LAS v4u* op = (const LAS v4u*)(lds + SC_OBUF + tok * SC_PITCH_A + seg * 32);
            const v4u o0 = op[0], o1 = op[1];
            float o[16] = {lo_bf(o0.x), hi_bf(o0.x), lo_bf(o0.y), hi_bf(o0.y), lo_bf(o0.z), hi_bf(o0.z), lo_bf(o0.w), hi_bf(o0.w),
                           lo_bf(o1.x), hi_bf(o1.x), lo_bf(o1.y), hi_bf(o1.y), lo_bf(o1.z), hi_bf(o1.z), lo_bf(o1.w), hi_bf(o1.w)};
            float ss = 0.f;
#pragma unroll
            for (int i = 0; i < 16; ++i) ss += o[i] * o[i];
            ss += __shfl_xor(ss, 1); ss += __shfl_xor(ss, 2); ss += __shfl_xor(ss, 4);
            const float rs = 1.f / sqrtf(ss * (1.f / 128.f) + RMS_EPS);
            const float z[16] = {lo_bf(z0.x), hi_bf(z0.x), lo_bf(z0.y), hi_bf(z0.y), lo_bf(z0.z), hi_bf(z0.z), lo_bf(z0.w), hi_bf(z0.w),
                                 lo_bf(z1.x), hi_bf(z1.x), lo_bf(z1.y), hi_bf(z1.y), lo_bf(z1.z), hi_bf(z1.z), lo_bf(z1.w), hi_bf(z1.w)};
            const float* gn = C.onorm() + seg * 16;
            float y[16];
#pragma unroll
            for (int i = 0; i < 16; ++i) y[i] = o[i] * rs * gn[i] * siluf_(z[i]);
            v4u w0, w1; w0.x = pk2(y[0], y[1]); w0.y = pk2(y[2], y[3]); w0.z = pk2(y[4], y[5]); w0.w = pk2(y[6], y[7]);
            w1.x = pk2(y[8], y[9]); w1.y = pk2(y[10], y[11]); w1.z = pk2(y[12], y[13]); w1.w = pk2(y[14], y[15]);
            v4u* og = (v4u*)(C.OG() + m * E + hv * 128 + seg * 16); og[0] = w0; og[1] = w1;
        }
        BAR_LDS();
    }
    if (wave < 4) {
        float* dp = C.out() + O_DELTAP + (size_t)bh * 16384 + 32 * wave + c32;
#pragma unroll
        for (int T = 0; T < 4; ++T)
#pragma unroll
            for (int r = 0; r < 16; ++r) { const int dk = 32 * T + (r & 3) + 8 * (r >> 2) + 4 * h; __builtin_nontemporal_store(S[T][r], dp + dk * 128); }
    }
}

__device__ __forceinline__ void gdn_sample_unit(const Ctx& C, LAS unsigned char* lds, int unit) {
    const int tid = fresh_tid(), lane = tid & 63, wave = tid >> 6;
    const int b = unit >> 5, hv = unit & 31, hq = hv >> 1; const size_t m = TP + b;
    LAS float* sv = (LAS float*)lds;
    LAS float* part = (LAS float*)(lds + 2048);
    LAS float* misc = (LAS float*)(lds + 2048 + 8192);
    const bf16* pr = C.P1() + m * N1P;
    const int dv4 = tid & 31, dk0 = tid >> 5;
    const f32x4* Sp = (const f32x4*)(C.ds() + (size_t)unit * 16384) + dv4;
    f32x4 S[8];
#pragma unroll
    for (int r = 0; r < 8; ++r) S[r] = __builtin_nontemporal_load(Sp + (dk0 + 16 * r) * 32);
    if (tid < 384) { const int tensor = tid >> 7, ch = tid & 127;
        const int cidx = tensor == 0 ? hq * 128 + ch : tensor == 1 ? 2048 + hq * 128 + ch : 4096 + hv * 128 + ch;
        const float* st = C.cs() + (size_t)b * 3 * 8192 + cidx;
        const float y = C.convw()[cidx] * st[0] + C.convw()[8192 + cidx] * st[8192] + C.convw()[2 * 8192 + cidx] * st[2 * 8192] + C.convw()[3 * 8192 + cidx] * bf2f(pr[cidx]);
        sv[tid] = siluf_(y); }
    BAR_LDS();
    if (wave < 2) { const float a0 = sv[wave * 128 + lane], a1 = sv[wave * 128 + 64 + lane]; float rn = 1.f / sqrtf(wave_sum(a0 * a0 + a1 * a1) + 1e-6f);
        if (wave == 0) rn *= 0.08838834764831845f;
        sv[wave * 128 + lane] = a0 * rn; sv[wave * 128 + 64 + lane] = a1 * rn; }
    BAR_LDS();
    if (wave == 0) { const float qk = wave_sum(sv[lane] * sv[128 + lane] + sv[64 + lane] * sv[192 + lane]); if (lane == 0) misc[0] = qk; }
    const float av = bf2f(pr[OFF_A + hv]), bv = bf2f(pr[OFF_B + hv]);
    const float xx = av + C.dtb()[hv]; const float sp = xx > 20.f ? xx : log1pf(__expf(xx));
    const float eg = __expf(-__expf(C.alog()[hv]) * sp), beta = sigmoidf_(bv);
    f32x4 ks = {0.f, 0.f, 0.f, 0.f}, qs = {0.f, 0.f, 0.f, 0.f};
#pragma unroll
    for (int r = 0; r < 8; ++r) { const float qd = sv[dk0 + 16 * r], kd = sv[128 + dk0 + 16 * r]; ks += S[r] * kd; qs += S[r] * qd; }
#pragma unroll
    for (int i = 0; i < 4; ++i) { ks[i] += __shfl_xor(ks[i], 32); qs[i] += __shfl_xor(qs[i], 32); }
    if (lane < 32) { *(LAS f32x4*)(part + wave * 128 + 4 * dv4) = ks; *(LAS f32x4*)(part + 1024 + wave * 128 + 4 * dv4) = qs; }
    BAR_LDS();
    ks = (f32x4){0.f, 0.f, 0.f, 0.f}; qs = ks;
#pragma unroll
    for (int w = 0; w < 8; ++w) { ks += *(const LAS f32x4*)(part + w * 128 + 4 * dv4); qs += *(const LAS f32x4*)(part + 1024 + w * 128 + 4 * dv4); }
    const f32x4 vv = *(const LAS f32x4*)(sv + 256 + 4 * dv4); const float qk = misc[0];
    const f32x4 vn = (vv - ks * eg) * beta;
    const f32x4 o = qs * eg + vn * qk;
    f32x4* So = (f32x4*)(C.out() + O_DELTAS + (size_t)unit * 16384) + dv4;
#pragma unroll
    for (int r = 0; r < 8; ++r) { const float kd = sv[128 + dk0 + 16 * r]; __builtin_nontemporal_store(S[r] * eg + vn * kd, So + (dk0 + 16 * r) * 32); }
    if (wave == 0) {
        float ss = o.x * o.x + o.y * o.y + o.z * o.z + o.w * o.w;
        ss += __shfl_xor(ss, 1); ss += __shfl_xor(ss, 2); ss += __shfl_xor(ss, 4); ss += __shfl_xor(ss, 8); ss += __shfl_xor(ss, 16);
        const float rs = 1.f / sqrtf(ss * (1.f / 128.f) + RMS_EPS);
        if (lane < 32) { const v2u zv = *(const v2u*)(pr + NZ + hv * 128 + 4 * dv4); const f32x4 gn = *(const f32x4*)(C.onorm() + 4 * dv4);
            v2u w; w.x = pk2(o.x * rs * gn.x * siluf_(lo_bf(zv.x)), o.y * rs * gn.y * siluf_(hi_bf(zv.x)));
            w.y = pk2(o.z * rs * gn.z * siluf_(lo_bf(zv.y)), o.w * rs * gn.w * siluf_(hi_bf(zv.y)));
            *(v2u*)(C.OG() + m * E + hv * 128 + 4 * dv4) = w; } }
    BAR_LDS();
}
__device__ __forceinline__ void phase3(const Ctx& C, LAS unsigned char* lds) {
    for (int bh = blockIdx.x; bh < NB * 32; bh += gridDim.x) gdn_scan_unit(C, lds, bh);
    LAS int* qslot = (LAS int*)(lds + 16384); const int qt = fresh_tid();
    for (;;) {
        if (qt == 0) *qslot = (int)atomicAdd(C.ctl() + 0, 1u);
        BAR_LDS();
        const int u = *qslot;
        BAR_LDS();
        if (u >= NSMP * 32) break;
        gdn_sample_unit(C, lds, u);
    }
}

constexpr int SS_SLOT = 36864, SS_HS = 17408, SS_HSB = 8704, SS_UL = 34816, SS_HS_PITCH = 272, SS_BU_PITCH = 272;
template <bool SAMPLE>
__device__ __forceinline__ void ssm_round(const Ctx& C, LAS unsigned char* lds, int ubase, int tid) {
    const int lane = tid & 63, wave = __builtin_amdgcn_readfirstlane(tid >> 6), slot = wave & 3, role = wave >> 2;
    const int u = ubase + slot, seq = u >> 8, g = u & 255;
    LAS unsigned char* wl = lds + slot * SS_SLOT;
    const int c32 = lane & 31, h = lane >> 5, c16 = lane & 15, q4 = lane >> 4;
    constexpr int nchunk = SAMPLE ? NSMP / 32 : SEQ / 32;
    const size_t mbase = SAMPLE ? (size_t)TP : (size_t)seq * SEQ;
    if (role == 0) {
        bf16x8 bb[4];
#pragma unroll
        for (int j = 0; j < 4; ++j) bb[j] = *(const bf16x8*)(C.BBT() + ((size_t)g * 128 + 32 * j + c32) * 16 + 8 * h);
        const float ar = C.AR()[g * 64 + lane], ai = C.AI()[g * 64 + lane];
        const f32x2_t A2 = {ar, ar}, B2 = {-ai, ai}; f32x2_t h2 = {0.f, 0.f};
        __builtin_amdgcn_s_setprio(1);
        const bf16* up = C.UZ() + (mbase + c32) * NZ + g * 16 + 8 * h;
        bf16x8 ring[4];
#pragma unroll
        for (int i = 0; i < 4; ++i) ring[i] = __builtin_nontemporal_load((const bf16x8*)(up + (size_t)i * 32 * NZ));
#pragma unroll 1
        for (int ck0 = 0; ck0 < nchunk; ck0 += 4) {
#pragma unroll
            for (int ci = 0; ci < 4; ++ci) { const int ck = ck0 + ci;
                const bf16x8 ua = ring[ci];
                ring[ci] = __builtin_nontemporal_load((const bf16x8*)(up + (size_t)(ck + 4 < nchunk ? ck + 4 : nchunk - 1) * 32 * NZ));
                LAS unsigned char* HS = wl + SS_HS + (ck & 1) * SS_HSB;
                *(LAS bf16x8*)(wl + SS_UL + (ck & 1) * 1024 + c32 * 32 + h * 16) = ua;
#pragma unroll
                for (int j2 = 0; j2 < 2; ++j2) { f32x16 aR, aI;
#pragma unroll
                    for (int r = 0; r < 16; ++r) { aR[r] = 0.f; aI[r] = 0.f; }
                    aR = MFMA32(ua, bb[j2], aR); aI = MFMA32(ua, bb[2 + j2], aI);
                    LAS unsigned char* bp = wl + (32 * j2 + c32) * SS_BU_PITCH + h * 32;
#pragma unroll
                    for (int g4 = 0; g4 < 4; ++g4)
#pragma unroll
                        for (int hh = 0; hh < 2; ++hh) { const int r0 = 4 * g4 + 2 * hh; const f32x4 v = {aR[r0], aI[r0], aR[r0 + 1], aI[r0 + 1]};
                            *(LAS f32x4*)(bp + (4 * g4 + hh) * 16) = v; } }
                {
                    const LAS unsigned char* rp = wl + lane * SS_BU_PITCH;
#pragma unroll
                    for (int q = 0; q < 16; ++q) { const f32x4 v = *(const LAS f32x4*)(rp + q * 16);
                        f32x2_t n0 = A2 * h2 + (B2 * __builtin_shufflevector(h2, h2, 1, 0) + (f32x2_t){v.x, v.y});
                        *(LAS unsigned*)(HS + (2 * q) * SS_HS_PITCH + lane * 4) = pk2(n0.x, n0.y);
                        f32x2_t n1 = A2 * n0 + (B2 * __builtin_shufflevector(n0, n0, 1, 0) + (f32x2_t){v.z, v.w});
                        *(LAS unsigned*)(HS + (2 * q + 1) * SS_HS_PITCH + lane * 4) = pk2(n1.x, n1.y);
                        h2 = n1; }
                }
                BAR_LDS();
            }
        }
        BAR_LDS();
        __builtin_amdgcn_s_setprio(0);
        if (!SAMPLE) { C.out()[O_REP + ((size_t)seq * 256 + g) * 64 + lane] = h2.x; C.out()[O_IMP + ((size_t)seq * 256 + g) * 64 + lane] = h2.y; }
    } else {
        bf16x8 cm[4];
#pragma unroll
        for (int s = 0; s < 4; ++s) cm[s] = *(const bf16x8*)(C.CMT() + ((size_t)g * 16 + c16) * 128 + 32 * s + 8 * q4);
        const float dsk = C.dssm()[g * 16 + c16];
        bf16* ygw = C.YG() + (mbase + (lane >> 1)) * E + g * 16 + (lane & 1) * 8;
        BAR_LDS();
#pragma unroll 1
        for (int cc = 0; cc < nchunk; ++cc) {
            {
                const LAS unsigned char* HS = wl + SS_HS + (cc & 1) * SS_HSB; const LAS unsigned char* UL = wl + SS_UL + (cc & 1) * 1024;
                LAS unsigned char* YL = wl + SS_HS + (cc & 1) * SS_HSB;
#pragma unroll
                for (int tt = 0; tt < 2; ++tt) { f32x4 y = {0.f, 0.f, 0.f, 0.f};
#pragma unroll
                    for (int s = 0; s < 4; ++s) { const bf16x8 a = *(const LAS bf16x8*)(HS + (16 * tt + c16) * SS_HS_PITCH + s * 64 + q4 * 16);
                        y = __builtin_amdgcn_mfma_f32_16x16x32_bf16(a, cm[s], y, 0, 0, 0); }
#pragma unroll
                    for (int r = 0; r < 4; ++r) { const int row = 16 * tt + 4 * q4 + r;
                        const float uv = bf2f(*(const LAS bf16*)(UL + row * 32 + c16 * 2));
                        *(LAS bf16*)(YL + row * 32 + c16 * 2) = f2bf(gelu_tanh(y[r] + dsk * uv)); } }
                *(v4u*)(ygw + (size_t)(cc * 32) * E) = *(const LAS v4u*)(YL + lane * 16); }
            BAR_LDS();
        }
    }
}
__device__ __forceinline__ void ssm_sample_unit(const Ctx& C, LAS unsigned char* wl, int g, int rb, int lane_in) {
    int lane = lane_in; asm volatile("" : "+v"(lane));
    const int c32 = lane & 31, h = lane >> 5, c16 = lane & 15, q4 = lane >> 4;
    const size_t m0 = (size_t)TP + rb * 32;
    const size_t sbase = ((size_t)(rb * 32) * 256 + g) * 64;
    const float* pr = C.sre() + sbase; const float* pi = C.sim() + sbase;
    float h0r[16], h0i[16];
#pragma unroll
    for (int r = 0; r < 16; ++r) { h0r[r] = __builtin_nontemporal_load((const float*)((const char*)pr + (unsigned)(r * 65536 + lane * 4))); h0i[r] = __builtin_nontemporal_load((const float*)((const char*)pi + (unsigned)(r * 65536 + lane * 4))); }
    const bf16x8 ua = *(const bf16x8*)(C.UZ() + (m0 + c32) * NZ + g * 16 + 8 * h);
    bf16x8 bb[4], cm[4];
#pragma unroll
    for (int j = 0; j < 4; ++j) bb[j] = *(const bf16x8*)(C.BBT() + ((size_t)g * 128 + 32 * j + c32) * 16 + 8 * h);
#pragma unroll
    for (int s = 0; s < 4; ++s) cm[s] = *(const bf16x8*)(C.CMT() + ((size_t)g * 16 + c16) * 128 + 32 * s + 8 * q4);
    const float ar = C.AR()[g * 64 + lane], ai = C.AI()[g * 64 + lane], dsk = C.dssm()[g * 16 + c16];
    LAS unsigned char* HS = wl + SS_HS; LAS unsigned char* UL = wl + SS_UL;
    *(LAS bf16x8*)(UL + c32 * 32 + h * 16) = ua;
#pragma unroll
    for (int j2 = 0; j2 < 2; ++j2) { f32x16 aR, aI;
#pragma unroll
        for (int r = 0; r < 16; ++r) { aR[r] = 0.f; aI[r] = 0.f; }
        aR = MFMA32(ua, bb[j2], aR); aI = MFMA32(ua, bb[2 + j2], aI);
        LAS unsigned char* bp = wl + (32 * j2 + c32) * SS_BU_PITCH + h * 32;
#pragma unroll
        for (int g4 = 0; g4 < 4; ++g4)
#pragma unroll
            for (int hh = 0; hh < 2; ++hh) { const int r0 = 4 * g4 + 2 * hh; const f32x4 v = {aR[r0], aI[r0], aR[r0 + 1], aI[r0 + 1]};
                *(LAS f32x4*)(bp + (4 * g4 + hh) * 16) = v; } }
    float* orp = C.out() + O_RES + sbase; float* oip = C.out() + O_IMS + sbase;
    const LAS unsigned char* rp = wl + lane * SS_BU_PITCH;
#pragma unroll
    for (int q = 0; q < 16; ++q) { const f32x4 v = *(const LAS f32x4*)(rp + q * 16);
        if (q == 8) {
#pragma unroll
            for (int r = 0; r < 16; ++r) { h0r[r] = *(const float*)((const char*)pr + (unsigned)((16 + r) * 65536 + lane * 4)); h0i[r] = *(const float*)((const char*)pi + (unsigned)((16 + r) * 65536 + lane * 4)); } }
#pragma unroll
        for (int e = 0; e < 2; ++e) { const int r = 2 * q + e; const float re = e ? v.z : v.x, im = e ? v.w : v.y;
            const float nr = ar * h0r[r & 15] - ai * h0i[r & 15] + re, ni = ar * h0i[r & 15] + ai * h0r[r & 15] + im;
            __builtin_nontemporal_store(nr, (float*)((char*)orp + (unsigned)(r * 65536 + lane * 4))); __builtin_nontemporal_store(ni, (float*)((char*)oip + (unsigned)(r * 65536 + lane * 4)));
            *(LAS unsigned*)(HS + r * SS_HS_PITCH + lane * 4) = pk2(nr, ni); } }
    bf16* yg = C.YG() + (m0 + 4 * q4) * E + g * 16 + c16;
#pragma unroll
    for (int tt = 0; tt < 2; ++tt) { f32x4 y = {0.f, 0.f, 0.f, 0.f};
#pragma unroll
        for (int s = 0; s < 4; ++s) { const bf16x8 a = *(const LAS bf16x8*)(HS + (16 * tt + c16) * SS_HS_PITCH + s * 64 + q4 * 16);
            y = __builtin_amdgcn_mfma_f32_16x16x32_bf16(a, cm[s], y, 0, 0, 0); }
#pragma unroll
        for (int r = 0; r < 4; ++r) { const int row = 16 * tt + 4 * q4 + r;
            const float uv = bf2f(*(const LAS bf16*)(UL + row * 32 + c16 * 2));
            yg[(size_t)(16 * tt + r) * E] = f2bf(gelu_tanh(y[r] + dsk * uv)); } }
}
__device__ __forceinline__ void phase7(const Ctx& C, LAS unsigned char* lds) {
    const int tid = fresh_tid();
    for (int ub = blockIdx.x * 4; ub < NB * 256; ub += gridDim.x * 4) ssm_round<false>(C, lds, ub, tid);
    const int lane = tid & 63, wave = __builtin_amdgcn_readfirstlane(tid >> 6);
    if (wave < 4) for (int u = blockIdx.x * 4 + wave; u < 1024; u += gridDim.x * 4) ssm_sample_unit(C, lds + wave * SS_SLOT, u & 255, u >> 8, lane);
}
__device__ __forceinline__ void grid_bar(unsigned* cnt, unsigned target) {
    __syncthreads();
    if (threadIdx.x == 0) {
        __builtin_amdgcn_fence(__ATOMIC_RELEASE, "agent");
        asm volatile("s_waitcnt vmcnt(0)" ::: "memory");
        __hip_atomic_fetch_add(cnt, 1u, __ATOMIC_RELAXED, __HIP_MEMORY_SCOPE_AGENT);
        unsigned spins = 0;
        while (__hip_atomic_load(cnt, __ATOMIC_RELAXED, __HIP_MEMORY_SCOPE_AGENT) < target && ++spins < (1u << 24)) __builtin_amdgcn_s_sleep(2);
        __builtin_amdgcn_fence(__ATOMIC_ACQUIRE, "agent");
    }
    __syncthreads();
}
__global__ void __launch_bounds__(512, 2) mk_fwd(Args a) {
    extern __shared__ __attribute__((aligned(16))) unsigned char lds_raw[];
    LAS unsigned char* lds = (LAS unsigned char*)lds_raw;
    cg::grid_group grid = cg::this_grid();
    const Ctx C{a};
    const int lo = a.ph_lo, hi = a.ph_hi; unsigned nbar = 0;
#ifdef ONLY
#define IN(k) ((k) == ONLY && lo <= (k) && (k) < hi)
#else
#define IN(k) (lo <= (k) && (k) < hi)
#endif
#define SEAM(k) do { if (IN(k) && IN((k) + 1)) { if ((k) == 0) grid.sync(); else { ++nbar; grid_bar(C.ctl() + 64, nbar * gridDim.x); } } } while (0)
    if (IN(0)) phase0(C, lds);
    SEAM(0);
    if (IN(1)) { pg8::Gemm g{C.H(), C.WT1(), TP, 12288, D}; pg8::StaticOrder S; S.init(TP, 12288, (int)gridDim.x, (int)blockIdx.x);
        EpiStore Ep{C.P1(), N1P}; if (!(a.flags & 2)) pg8::gemm_phase<EpiStore, pg8::StaticOrder, true, true>(lds, g, S, Ep);
        const int t1 = fresh_tid(), lane = t1 & 63, wave = __builtin_amdgcn_readfirstlane(t1 >> 6), i16 = lane & 15, q4 = lane >> 4;
        if (!(a.flags & 1)) {
            bf16* P1 = C.P1();
            for (int job = blockIdx.x; job < TP / 32; job += gridDim.x) { const int r0 = job * 32 + (wave >> 2) * 16, c0 = OFF_B + (wave & 3) * 16;
                skinny_wg<4, 1, D, D>(C.H() + (size_t)r0 * D, D, C.WT1() + (size_t)OFF_B * D, lds, t1, wave & 3, job >> 3, [&](int j, const f32x4 v) {
                    *(v2u*)(P1 + (size_t)(r0 + i16) * N1P + c0 + 4 * q4) = pk4(v); }); }
            for (int job = blockIdx.x; job < N1 / 64; job += gridDim.x) { const int r0 = TP + wave * 16, c0 = job * 64;
                skinny_wg<4, 4, D, D>(C.H() + (size_t)r0 * D, D, C.WT1() + (size_t)c0 * D, lds, t1, 0, job >> 3, [&](int j, const f32x4 v) {
                    *(v2u*)(P1 + (size_t)(r0 + i16) * N1P + c0 + 16 * j + 4 * q4) = pk4(v); }); }
        } }
    SEAM(1);
    if (IN(2)) phase2(C, lds);
    SEAM(2);
    if (IN(3)) phase3(C, lds);
    SEAM(3);
    if (IN(4)) { pg8::Gemm g{C.OG(), C.WT2(), TP, D, E}; pg8::StaticOrder S; S.init(TP, D, (int)gridDim.x, (int)blockIdx.x);
        EpiResid Ep{C.xp(), C.xs(), C.X1()}; if (!(a.flags & 2)) pg8::gemm_phase<EpiResid, pg8::StaticOrder, true, true>(lds, g, S, Ep);
        const int t1 = fresh_tid(), lane = t1 & 63, wave = __builtin_amdgcn_readfirstlane(t1 >> 6), i16 = lane & 15, q4 = lane >> 4;
        if (!(a.flags & 1)) {   float* X1 = C.X1(); const float* xs = C.xs();
            for (int job = blockIdx.x; job < 2 * (D / 16); job += gridDim.x) { const int r0 = TP + wave * 16, c0 = (job >> 1) * 16, kh = (job & 1) * (E / 2);
                skinny_wg<1, 1, E / 2, E>(C.OG() + (size_t)r0 * E + kh, E, C.WT2() + (size_t)c0 * E + kh, lds, t1, 0, job >> 3, [&](int j, const f32x4 v) {
                    float* p = X1 + (size_t)(r0 + i16) * D + c0 + 4 * q4;
                    atomicAdd(p, v[0]); atomicAdd(p + 1, v[1]); atomicAdd(p + 2, v[2]); atomicAdd(p + 3, v[3]); }); } } }
    SEAM(4);
    if (IN(5)) { const int t5 = fresh_tid(), lane = t5 & 63, gw = blockIdx.x * 8 + (t5 >> 6), NGW = gridDim.x * 8; for (int m = gw; m < MV; m += NGW) rms_row_bf16(C.X1() + (size_t)m * D, C.nssm(), C.H() + (size_t)m * D, lane); }
    SEAM(5);
    if (IN(6)) { pg8::Gemm g{C.H(), C.WT3(), TP, NZ, D}; pg8::StaticOrder S; S.init(TP, NZ, (int)gridDim.x, (int)blockIdx.x);
        EpiStore Ep{C.UZ(), NZ}; if (!(a.flags & 2)) pg8::gemm_phase<EpiStore, pg8::StaticOrder, true, true>(lds, g, S, Ep);
        const int t1 = fresh_tid(), lane = t1 & 63, wave = __builtin_amdgcn_readfirstlane(t1 >> 6), i16 = lane & 15, q4 = lane >> 4;
        if (!(a.flags & 1)) {   bf16* UZ = C.UZ();
            for (int job = blockIdx.x; job < NZ / 32; job += gridDim.x) { const int r0 = TP + wave * 16, c0 = job * 32;
                skinny_wg<2, 2, D, D>(C.H() + (size_t)r0 * D, D, C.WT3() + (size_t)c0 * D, lds, t1, 0, job >> 3, [&](int j, const f32x4 v) {
                    *(v2u*)(UZ + (size_t)(r0 + i16) * NZ + c0 + 16 * j + 4 * q4) = pk4(v); }); } } }
    SEAM(6);
    if (IN(7)) phase7(C, lds);
    SEAM(7);
    if (IN(8)) { pg8::Gemm g{C.YG(), C.WT4(), TP, E, E}; pg8::StaticOrder S; S.init(TP, E, (int)gridDim.x, (int)blockIdx.x);
        EpiGlu Ep{C.YG(), C.UZ(), C.bglu(), C.Y2()}; if (!(a.flags & 2)) pg8::gemm_phase<EpiGlu, pg8::StaticOrder, true, true>(lds, g, S, Ep);
        const int t1 = fresh_tid(), lane = t1 & 63, wave = __builtin_amdgcn_readfirstlane(t1 >> 6), i16 = lane & 15, q4 = lane >> 4;
        if (!(a.flags & 1)) {   bf16* Y2 = C.Y2(); const bf16* YG = C.YG(); const bf16* UZ = C.UZ(); const float* bg = C.bglu();
            for (int job = blockIdx.x; job < E / 16; job += gridDim.x) { const int r0 = TP + wave * 16, c0 = job * 16;
                skinny_wg<1, 1, E, E>(YG + (size_t)r0 * E, E, C.WT4() + (size_t)c0 * E, lds, t1, 0, job >> 3, [&](int j, const f32x4 v) {
                    const size_t r = r0 + i16; const int c = c0 + 4 * q4;
                    const v2u yv = *(const v2u*)(YG + r * E + c), zv = *(const v2u*)(UZ + r * NZ + E + c); const f32x4 gt = v + *(const f32x4*)(bg + c);
                    f32x4 o; o[0] = lo_bf(yv.x) * sigmoidf_(gt[0]) * siluf_(lo_bf(zv.x)); o[1] = hi_bf(yv.x) * sigmoidf_(gt[1]) * siluf_(hi_bf(zv.x));
                    o[2] = lo_bf(yv.y) * sigmoidf_(gt[2]) * siluf_(lo_bf(zv.y)); o[3] = hi_bf(yv.y) * sigmoidf_(gt[3]) * siluf_(hi_bf(zv.y));
                    *(v2u*)(Y2 + r * E + c) = pk4(o); }); } } }
    SEAM(8);
    if (IN(9)) { pg8::Gemm g{C.Y2(), C.WT5(), TP, D, E}; pg8::StaticOrder S; S.init(TP, D, (int)gridDim.x, (int)blockIdx.x);
        EpiResid2 Ep{C.X1()}; if (!(a.flags & 2)) pg8::gemm_phase<EpiResid2, pg8::StaticOrder, true, true>(lds, g, S, Ep);
        const int t1 = fresh_tid(), lane = t1 & 63, wave = __builtin_amdgcn_readfirstlane(t1 >> 6), i16 = lane & 15, q4 = lane >> 4;
        if (!(a.flags & 1)) {   float* X1 = C.X1();
            for (int job = blockIdx.x; job < 2 * (D / 16); job += gridDim.x) { const int r0 = TP + wave * 16, c0 = (job >> 1) * 16, kh = (job & 1) * (E / 2);
                skinny_wg<1, 1, E / 2, E>(C.Y2() + (size_t)r0 * E + kh, E, C.WT5() + (size_t)c0 * E + kh, lds, t1, 0, job >> 3, [&](int j, const f32x4 v) {
                    float* p = X1 + (size_t)(r0 + i16) * D + c0 + 4 * q4;
                    atomicAdd(p, v[0]); atomicAdd(p + 1, v[1]); atomicAdd(p + 2, v[2]); atomicAdd(p + 3, v[3]); }); } } }
    SEAM(9);
    if (IN(10)) { const int t10 = fresh_tid(), lane = t10 & 63, gw = blockIdx.x * 8 + (t10 >> 6), NGW = gridDim.x * 8; for (int m = gw; m < MV; m += NGW) rms_row_f32(C.X1() + (size_t)m * D, C.nfin(), m < TP ? C.out() + O_YP + (size_t)m * D : C.out() + O_YS + (size_t)(m - TP) * D, lane); }
}

#ifndef MK_SPLIT
#define MK_SPLIT 0
#endif
extern "C" void kernel_launch(void* const* d_in, const int* in_sizes, int n_in, void* d_out, int out_size, void* d_ws, size_t ws_size, hipStream_t stream) {
    static int grid = 0;
    if (grid == 0) {
        if (n_in != 27 || (size_t)out_size != O_END || ws_size < WS_END) { fprintf(stderr, "kernel_launch: unexpected problem (n_in %d, out %d, ws %zu)\n", n_in, out_size, ws_size); grid = -1; return; }
        int dev = 0, cus = 0, per_cu = 0;
        if (hipGetDevice(&dev) != hipSuccess || hipDeviceGetAttribute(&cus, hipDeviceAttributeMultiprocessorCount, dev) != hipSuccess) { grid = -1; return; }
        if (hipFuncSetAttribute((const void*)mk_fwd, hipFuncAttributeMaxDynamicSharedMemorySize, LDS_BYTES) != hipSuccess) { fprintf(stderr, "kernel_launch: hipFuncSetAttribute failed\n"); grid = -1; return; }
        if (hipOccupancyMaxActiveBlocksPerMultiprocessor(&per_cu, (const void*)mk_fwd, 512, LDS_BYTES) != hipSuccess || per_cu < 1) { fprintf(stderr, "kernel_launch: occupancy query says %d\n", per_cu); (void)hipGetLastError(); grid = -1; return; }
        grid = cus;
    }
    if (grid < 0) return;
    (void)hipMemsetAsync((char*)d_ws + WS_CTL, 0, 4096, stream);
    Args a{};
    for (int i = 0; i < 27; ++i) a.in[i] = (const float*)d_in[i];
    a.out = (float*)d_out; a.ws = (unsigned char*)d_ws;
#if MK_SPLIT
    for (int p = 0; p <= 10; ++p) { a.ph_lo = p; a.ph_hi = p + 1; hipLaunchKernelGGL(mk_fwd, dim3(grid), dim3(512), LDS_BYTES, stream, a); }
#else
    a.ph_lo = 0; a.ph_hi = 11;
    void* args[] = {&a};
    hipError_t e = hipLaunchCooperativeKernel((const void*)mk_fwd, dim3(grid), dim3(512), args, LDS_BYTES, stream);
    if (e != hipSuccess) fprintf(stderr, "kernel_launch: cooperative launch failed: %s (grid %d)\n", hipGetErrorString(e), grid);
#endif
#ifdef PROBE_EXTRA
    for (int p = 0; p <= 11; ++p) if ((PROBE_EXTRA >> p) & 1) {
        if (p == 3) (void)hipMemsetAsync((char*)d_ws + WS_CTL, 0, 4096, stream);
        a.ph_lo = p; a.ph_hi = p + 1; a.out = (float*)((char*)d_ws + 64 * MiB);
#ifdef PROBE_FLAGS
        a.flags = PROBE_FLAGS;
#endif
        hipLaunchKernelGGL(mk_fwd, dim3(grid), dim3(512), LDS_BYTES, stream, a); }
#endif
}
```

```cpp
#include <hip/hip_runtime.h>
#include <hip/hip_cooperative_groups.h>
#include <cstdio>
#include <cstdint>
namespace cg = cooperative_groups;
namespace pg8 {
#define PG8_LAS __attribute__((address_space(3)))
typedef unsigned short bf16_t;
typedef short bf16x8 __attribute__((ext_vector_type(8)));
typedef float f32x4 __attribute__((ext_vector_type(4)));
typedef unsigned u32x4 __attribute__((ext_vector_type(4)));
constexpr int BM = 256, BK = 64, HALF = 128, HTB = HALF * BK * 2  , STAGE_BYTES = 8 * HTB, NXCD = 8, WGM = 4;

__host__ __device__ __forceinline__ int lds_byte(int r, int c) { const int st = (r >> 4) * 2 + (c >> 5), rr = r & 15, cc = c & 31, ob = rr * 64 + cc * 2; return st * 1024 + (ob ^ (((ob >> 9) & 1) << 5)); }
__host__ __device__ __forceinline__ void stage_rc(int b, int& R, int& C) { const int st = b / 1024, sb = b % 1024, swz = sb ^ (((sb >> 9) & 1) << 5); R = (st >> 1) * 16 + swz / 64; C = (st & 1) * 32 + (swz % 64) / 2; }
__host__ __device__ __forceinline__ int perm32(int rho) { const int n = rho >> 4, i = rho & 15; return 8 * (i >> 2) + 4 * n + (i & 3); }

struct Unit { int pm, pn; };
struct Gemm { const bf16_t* A; const bf16_t* Bt; int M, N, K; };

struct StaticOrder {
    int nM, nN, nwg, G, c;
    __host__ __device__ void init(int M, int N, int G_, int c_) { nM = M / BM; nN = N / BM; nwg = nM * nN; G = G_; c = c_; }
    __host__ __device__ bool next(int i, Unit& u) const {
        const long L = (long)i * G + c; if (L >= nwg) return false;
        int wgid = (int)L; { const int q = nwg / NXCD, r = nwg % NXCD, xcd = wgid % NXCD, off = wgid / NXCD; wgid = (xcd < r ? xcd * (q + 1) : r * (q + 1) + (xcd - r) * q) + off; }
        const int nig = WGM * nN, gid = wgid / nig, fm = gid * WGM, gsz = (nM - fm) < WGM ? (nM - fm) : WGM;
        u.pm = fm + ((wgid % nig) % gsz); u.pn = (wgid % nig) / gsz; return true;
    }
    __device__ __forceinline__ void a_ready(const Unit&) const {}
    __device__ __forceinline__ void done(const Unit&) const {}
};

__device__ __forceinline__ unsigned cvt_pk_bf16(float lo, float hi) { unsigned r; asm volatile("v_cvt_pk_bf16_f32 %0, %1, %2" : "=v"(r) : "v"(lo), "v"(hi)); return r; }

template <class Epi, class Sched, bool ALIGN_EPI = false, bool SP2 = false>
__device__ __forceinline__ void gemm_phase(PG8_LAS unsigned char* lds, const Gemm g, const Sched& S, const Epi& E) {
    const int tid = threadIdx.x, wid = __builtin_amdgcn_readfirstlane(tid >> 6), lane = tid & 63, wr = wid >> 2, wc = wid & 3, fr = lane & 15, fq = lane >> 4;
    const int K = g.K, nt = K / BK;
    unsigned voffA[2], voffB[2];
#pragma unroll
    for (int i = 0; i < 2; ++i) { int R, C; stage_rc(tid * 16 + i * 8192, R, C); const int Rb = Epi::PERM ? ((R & ~31) + perm32(R & 31)) : R;
        voffA[i] = (unsigned)(R * K + C) * 2u; voffB[i] = (unsigned)(Rb * K + C) * 2u; }
    const size_t kstep = (size_t)(BK * 2);
    const size_t hstep = (size_t)HALF * K * 2;
    const size_t tstep = 2 * hstep;
    const unsigned ldsw = (unsigned)wid * 1024u;
    const int aoff = lds_byte(wr * 64 + fr, fq * 8), boff = lds_byte(wc * 32 + fr, fq * 8);
#define PG8_SA(b, h) (((b) * 2 + (h)) * HTB)
#define PG8_SB(b, h) ((4 + (b) * 2 + (h)) * HTB)
#define PG8_STAGE(bufoff, gbase, voff) do { _Pragma("unroll") for (int _i = 0; _i < 2; ++_i) \
        __builtin_amdgcn_global_load_lds((const unsigned*)((const char*)(gbase) + (voff)[_i]), (PG8_LAS unsigned*)(lds + (bufoff) + ldsw + _i * 8192), 16, 0, 0); } while (0)
#define PG8_LDA(dst, b, h) do { _Pragma("unroll") for (int m = 0; m < 4; ++m) _Pragma("unroll") for (int k = 0; k < 2; ++k) dst[m][k] = *(const PG8_LAS bf16x8*)(lds + PG8_SA(b, h) + aoff + m * 2048 + k * 1024); } while (0)
#define PG8_LDB(dst, b, h) do { _Pragma("unroll") for (int n = 0; n < 2; ++n) _Pragma("unroll") for (int k = 0; k < 2; ++k) dst[n][k] = *(const PG8_LAS bf16x8*)(lds + PG8_SB(b, h) + boff + n * 2048 + k * 1024); } while (0)
#define PG8_MMA(ai, bj, At, Bt) do { __builtin_amdgcn_s_setprio(1); _Pragma("unroll") for (int m = 0; m < 4; ++m) _Pragma("unroll") for (int n = 0; n < 2; ++n) _Pragma("unroll") for (int k = 0; k < 2; ++k) \
        acc[ai][bj][m][n] = __builtin_amdgcn_mfma_f32_16x16x32_bf16(Bt[n][k], At[m][k], acc[ai][bj][m][n], 0, 0, 0); __builtin_amdgcn_s_setprio(0); } while (0)
#define PG8_WAIT_V(n) asm volatile("s_waitcnt vmcnt(" #n ")" ::: "memory")
#define PG8_WAIT_L(n) asm volatile("s_waitcnt lgkmcnt(" #n ")" ::: "memory")
#define PG8_BAR __builtin_amdgcn_s_barrier()
#define PG8_SCHED __builtin_amdgcn_sched_barrier(0)
    Unit cur, nxt; int ui = 0;
    if (!S.next(0, cur)) return;
    f32x4 acc[2][2][4][2];
#pragma unroll
    for (int a = 0; a < 2; ++a)
#pragma unroll
        for (int b = 0; b < 2; ++b)
#pragma unroll
            for (int m = 0; m < 4; ++m)
#pragma unroll
                for (int n = 0; n < 2; ++n) acc[a][b][m][n] = (f32x4){0.f, 0.f, 0.f, 0.f};
    bf16x8 At[4][2], B0[2][2], B1[2][2];
    const char* cA = (const char*)g.A + (size_t)cur.pm * tstep; const char* cB = (const char*)g.Bt + (size_t)cur.pn * tstep;
    S.a_ready(cur);
    if constexpr (SP2) {
        PG8_STAGE(PG8_SB(0, 0), cB, voffB); PG8_STAGE(PG8_SB(0, 1), cB + hstep, voffB); PG8_STAGE(PG8_SA(0, 0), cA, voffA); PG8_STAGE(PG8_SA(0, 1), cA + hstep, voffA);
        if (wr == 1) PG8_BAR;
        PG8_WAIT_V(2); PG8_BAR;
        PG8_STAGE(PG8_SB(1, 0), cB + kstep, voffB); PG8_STAGE(PG8_SA(1, 0), cA + kstep, voffA); PG8_STAGE(PG8_SB(1, 1), cB + hstep + kstep, voffB);
        PG8_WAIT_V(6); PG8_BAR;
    } else {
        PG8_STAGE(PG8_SB(0, 0), cB, voffB); PG8_STAGE(PG8_SA(0, 0), cA, voffA); PG8_STAGE(PG8_SB(0, 1), cB + hstep, voffB); PG8_STAGE(PG8_SA(0, 1), cA + hstep, voffA);
        if (wr == 1) PG8_BAR;
        PG8_WAIT_V(4); PG8_BAR;
        PG8_STAGE(PG8_SB(1, 0), cB + kstep, voffB); PG8_STAGE(PG8_SA(1, 0), cA + kstep, voffA); PG8_STAGE(PG8_SB(1, 1), cB + hstep + kstep, voffB);
        PG8_WAIT_V(6); PG8_BAR;
    }
    for (;;) {
        const bool has_next = S.next(ui + 1, nxt);
        const char* nA = has_next ? (const char*)g.A + (size_t)nxt.pm * tstep : cA; const char* nB = has_next ? (const char*)g.Bt + (size_t)nxt.pn * tstep : cB;
        for (int t = 0; t < nt; t += 2) {
            const bool last = (t == nt - 2);
            const char* a1 = cA + (size_t)(t + 1) * kstep;
            const char* a2 = last ? nA : cA + (size_t)(t + 2) * kstep; const char* b2 = last ? nB : cB + (size_t)(t + 2) * kstep;
            const char* a3 = a2 + kstep; const char* b3 = b2 + kstep;
            if (last && has_next) S.a_ready(nxt);
            if constexpr (SP2) {
            PG8_LDB(B0, 0, 0); PG8_LDB(B1, 0, 1); PG8_SCHED; PG8_LDA(At, 0, 0); PG8_STAGE(PG8_SA(1, 1), a1 + hstep, voffA);
            PG8_WAIT_V(8); PG8_WAIT_L(0); PG8_BAR; PG8_MMA(0, 0, At, B0); PG8_MMA(0, 1, At, B1); PG8_BAR; PG8_SCHED;
            PG8_LDA(At, 0, 1); PG8_STAGE(PG8_SB(0, 0), b2, voffB); PG8_STAGE(PG8_SB(0, 1), b2 + hstep, voffB); PG8_STAGE(PG8_SA(0, 0), a2, voffA);
            PG8_WAIT_V(8); PG8_WAIT_L(0); PG8_BAR; PG8_MMA(1, 0, At, B0); PG8_MMA(1, 1, At, B1); PG8_BAR; PG8_SCHED;
            PG8_LDB(B0, 1, 0); PG8_LDB(B1, 1, 1); PG8_SCHED; PG8_LDA(At, 1, 0); PG8_STAGE(PG8_SA(0, 1), a2 + hstep, voffA);
            PG8_WAIT_V(8); PG8_WAIT_L(0); PG8_BAR; PG8_MMA(0, 0, At, B0); PG8_MMA(0, 1, At, B1); PG8_BAR; PG8_SCHED;
            PG8_LDA(At, 1, 1); PG8_STAGE(PG8_SB(1, 0), b3, voffB); PG8_STAGE(PG8_SB(1, 1), b3 + hstep, voffB); PG8_STAGE(PG8_SA(1, 0), a3, voffA);
            PG8_WAIT_V(8); PG8_WAIT_L(0); PG8_BAR; PG8_MMA(1, 0, At, B0); PG8_MMA(1, 1, At, B1); PG8_BAR; PG8_SCHED;
            } else {
            PG8_LDB(B0, 0, 0); PG8_SCHED; PG8_LDA(At, 0, 0); PG8_STAGE(PG8_SA(1, 1), a1 + hstep, voffA);
            PG8_WAIT_L(8); PG8_BAR; PG8_WAIT_L(0); PG8_MMA(0, 0, At, B0); PG8_BAR; PG8_SCHED;
            PG8_LDB(B1, 0, 1); PG8_STAGE(PG8_SB(0, 0), b2, voffB);
            PG8_BAR; PG8_WAIT_L(0); PG8_MMA(0, 1, At, B1); PG8_BAR;
            PG8_LDA(At, 0, 1); PG8_STAGE(PG8_SA(0, 0), a2, voffA);
            PG8_BAR; PG8_WAIT_L(0); PG8_MMA(1, 0, At, B0); PG8_BAR; PG8_SCHED;
            PG8_STAGE(PG8_SB(0, 1), b2 + hstep, voffB);
            PG8_WAIT_V(6); PG8_BAR; PG8_MMA(1, 1, At, B1); PG8_BAR;
            PG8_LDB(B0, 1, 0); PG8_SCHED; PG8_LDA(At, 1, 0); PG8_STAGE(PG8_SA(0, 1), a2 + hstep, voffA);
            PG8_WAIT_L(8); PG8_BAR; PG8_WAIT_L(0); PG8_MMA(0, 0, At, B0); PG8_BAR; PG8_SCHED;
            PG8_LDB(B1, 1, 1); PG8_STAGE(PG8_SB(1, 0), b3, voffB);
            PG8_BAR; PG8_WAIT_L(0); PG8_MMA(0, 1, At, B1); PG8_BAR;
            PG8_LDA(At, 1, 1); PG8_STAGE(PG8_SA(1, 0), a3, voffA);
            PG8_BAR; PG8_WAIT_L(0); PG8_MMA(1, 0, At, B0); PG8_BAR; PG8_SCHED;
            PG8_STAGE(PG8_SB(1, 1), b3 + hstep, voffB);
            PG8_WAIT_V(6); PG8_BAR; PG8_MMA(1, 1, At, B1); PG8_BAR;
            }
        }
        if constexpr (ALIGN_EPI) { if (wr == 0) PG8_BAR; }
        if constexpr (!Epi::AFTER_DRAIN) { E(acc, cur, wr, wc, fr, fq); S.done(cur); }
        if (!has_next) break;
#pragma unroll
        for (int a = 0; a < 2; ++a)
#pragma unroll
            for (int b = 0; b < 2; ++b)
#pragma unroll
                for (int m = 0; m < 4; ++m)
#pragma unroll
                    for (int n = 0; n < 2; ++n) acc[a][b][m][n] = (f32x4){0.f, 0.f, 0.f, 0.f};
        cur = nxt; cA = nA; cB = nB; ++ui;
        if constexpr (ALIGN_EPI) { if (wr == 1) PG8_BAR; }
    }
    PG8_WAIT_V(0);
    if constexpr (!ALIGN_EPI) { if (wr == 0) PG8_BAR; }
    PG8_BAR;
    if constexpr (Epi::AFTER_DRAIN) { E.fused(acc, cur, wr, wc, fr, fq, lds, wid, lane); S.done(cur); }
#undef PG8_SA
#undef PG8_SB
#undef PG8_STAGE
#undef PG8_LDA
#undef PG8_LDB
#undef PG8_MMA
#undef PG8_WAIT_V
#undef PG8_WAIT_L
#undef PG8_BAR
#undef PG8_SCHED
}
}

#define LAS __attribute__((address_space(3)))
typedef unsigned short bf16;
typedef unsigned v4u __attribute__((ext_vector_type(4)));
typedef unsigned v2u __attribute__((ext_vector_type(2)));
typedef float f32x4 __attribute__((ext_vector_type(4)));
typedef float f32x16 __attribute__((ext_vector_type(16)));
typedef short bf16x8 __attribute__((ext_vector_type(8)));
typedef __bf16 bf16x2_t __attribute__((ext_vector_type(2)));
typedef float f32x2_t __attribute__((ext_vector_type(2)));

constexpr int D = 2048, TP = 8192, NSMP = 128, MV = TP + NSMP, MP = 8448;
constexpr int SEQ = 2048, NB = 4;
constexpr int N1 = 12352, N1P = 12544;
constexpr int E = 4096;
constexpr int NZ = 8192;
constexpr int OFF_B = 12288, OFF_A = 12320;
constexpr int LDS_BYTES = 147456;
constexpr float RMS_EPS = 1e-6f;

constexpr size_t MiB = 1u << 20;
constexpr size_t WS_CTL = 0;
constexpr size_t WS_WT1 = 1 * MiB, WS_WT2 = 50 * MiB, WS_WT3 = 66 * MiB, WS_WT4 = 98 * MiB, WS_WT5 = 130 * MiB;
constexpr size_t WS_AR = 146 * MiB, WS_AI = WS_AR + 65536, WS_GL = WS_AI + 65536, WS_BBT = 147 * MiB, WS_CMT = 148 * MiB;
constexpr size_t WS_H = 149 * MiB;
constexpr size_t WS_P1 = 182 * MiB;
constexpr size_t WS_UZ = WS_P1;
constexpr size_t WS_REC = 385 * MiB;
constexpr size_t WS_YG = WS_REC, WS_Y2 = WS_REC + 66 * MiB;
constexpr size_t WS_OG = 673 * MiB;
constexpr size_t WS_X1 = 739 * MiB;
constexpr size_t WS_END = 805 * MiB;
constexpr int REC_BYTES = 73728, REC_WN = 0, REC_QD = 16384, REC_AT = 32768, REC_KDT = 40960, REC_UT = 57344;

constexpr size_t O_YP = 0, O_YS = 16777216, O_CONVP = O_YS + 262144, O_DELTAP = O_CONVP + 98304, O_REP = O_DELTAP + 2097152, O_IMP = O_REP + 65536,
                 O_CONVS = O_IMP + 65536, O_DELTAS = O_CONVS + 3145728, O_RES = O_DELTAS + 67108864, O_IMS = O_RES + 2097152, O_END = O_IMS + 2097152;

__device__ __forceinline__ float bf2f(unsigned short u) { return __uint_as_float((unsigned)u << 16); }
__device__ __forceinline__ unsigned pk2(float lo, float hi) { f32x2_t v = {lo, hi}; bf16x2_t b = __builtin_convertvector(v, bf16x2_t); return __builtin_bit_cast(unsigned, b); }
__device__ __forceinline__ unsigned short f2bf(float f) { return (unsigned short)(pk2(f, 0.f) & 0xffffu); }
__device__ __forceinline__ float lo_bf(unsigned u) { return __uint_as_float(u << 16); }
__device__ __forceinline__ float hi_bf(unsigned u) { return __uint_as_float(u & 0xffff0000u); }
__device__ __forceinline__ float wave_sum(float v) {
#pragma unroll
    for (int o = 1; o < 64; o <<= 1) v += __shfl_xor(v, o);
    return v;
}
__device__ __forceinline__ float sigmoidf_(float x) { return __builtin_amdgcn_rcpf(1.f + __expf(-x)); }
__device__ __forceinline__ float siluf_(float x) { return x * __builtin_amdgcn_rcpf(1.f + __expf(-x)); }
__device__ __forceinline__ float gelu_tanh(float x) {
    const float u = 0.7978845608028654f * (x + 0.044715f * x * x * x);
    const float t = 1.f - 2.f * __builtin_amdgcn_rcpf(1.f + __expf(2.f * u));
    return 0.5f * x * (1.f + t);
}
#define LDS_WAIT() asm volatile("s_waitcnt lgkmcnt(0)" ::: "memory")
#define MFMA32(a, b, c) __builtin_amdgcn_mfma_f32_32x32x16_bf16((a), (b), (c), 0, 0, 0)
#define BAR_LDS() do { asm volatile("s_waitcnt lgkmcnt(0)" ::: "memory"); __builtin_amdgcn_s_barrier(); asm volatile("" ::: "memory"); } while (0)
__device__ __forceinline__ int fresh_tid() { int t = threadIdx.x; asm volatile("" : "+v"(t)); return t; }

struct Args { const float* in[27]; float* out; unsigned char* ws; int ph_lo, ph_hi, flags, pad; };
struct Ctx {
    const Args& a;
#define CIN(name, k) __device__ __forceinline__ const float* name() const { return a.in[k]; }
    CIN(xp, 0) CIN(xs, 1) CIN(cs, 2) CIN(ds, 3) CIN(sre, 4) CIN(sim, 5) CIN(ng, 6) CIN(wing, 7) CIN(convw, 8) CIN(alog, 9) CIN(dtb, 10) CIN(onorm, 11) CIN(woutg, 12) CIN(nssm, 13)
    CIN(wins, 14) CIN(lre, 15) CIN(lim, 16) CIN(bre, 17) CIN(bim, 18) CIN(cre, 19) CIN(cim, 20) CIN(dssm, 21) CIN(logdt, 22) CIN(wglu, 23) CIN(bglu, 24) CIN(wouts, 25) CIN(nfin, 26)
#undef CIN
    __device__ __forceinline__ float* out() const { return a.out; }
#define CWS(type, name, off) __device__ __forceinline__ type* name() const { return (type*)(a.ws + (off)); }
    CWS(bf16, WT1, WS_WT1) CWS(bf16, WT2, WS_WT2) CWS(bf16, WT3, WS_WT3) CWS(bf16, WT4, WS_WT4) CWS(bf16, WT5, WS_WT5) CWS(bf16, H, WS_H) CWS(bf16, P1, WS_P1) CWS(bf16, OG, WS_OG)
    CWS(bf16, UZ, WS_UZ) CWS(bf16, YG, WS_YG) CWS(bf16, Y2, WS_Y2) CWS(bf16, BBT, WS_BBT) CWS(bf16, CMT, WS_CMT) CWS(float, X1, WS_X1) CWS(float, AR, WS_AR) CWS(float, AI, WS_AI)
    CWS(float, GL, WS_GL) CWS(unsigned char, REC, WS_REC) CWS(unsigned, ctl, WS_CTL)
#undef CWS
};

struct EpiStore {
    static constexpr bool PERM = true, AFTER_DRAIN = false;
    bf16* O; int ldc;
    __device__ __forceinline__ void operator()(const pg8::f32x4 (&acc)[2][2][4][2], const pg8::Unit& u, int wr, int wc, int fr, int fq) const {
        const int row0 = u.pm * 256 + wr * 64 + fr, col0 = u.pn * 256 + wc * 32 + 8 * fq;
#pragma unroll
        for (int ai = 0; ai < 2; ++ai)
#pragma unroll
            for (int m = 0; m < 4; ++m) { bf16* rowp = O + (size_t)(row0 + ai * 128 + m * 16) * ldc + col0;
#pragma unroll
                for (int bj = 0; bj < 2; ++bj) { const pg8::f32x4 v0 = acc[ai][bj][m][0], v1 = acc[ai][bj][m][1];
                    v4u w; w.x = pk2(v0[0], v0[1]); w.y = pk2(v0[2], v0[3]); w.z = pk2(v1[0], v1[1]); w.w = pk2(v1[2], v1[3]);
                    *(v4u*)(rowp + bj * 128) = w; } }
    }
};
struct EpiResid {
    static constexpr bool PERM = true, AFTER_DRAIN = false;
    const float* xp; const float* xs; float* X1;
    __device__ __forceinline__ void operator()(const pg8::f32x4 (&acc)[2][2][4][2], const pg8::Unit& u, int wr, int wc, int fr, int fq) const {
        const int row0 = u.pm * 256 + wr * 64 + fr, col0 = u.pn * 256 + wc * 32 + 8 * fq;
#pragma unroll
        for (int ai = 0; ai < 2; ++ai)
#pragma unroll
            for (int m = 0; m < 4; ++m) { const int r = row0 + ai * 128 + m * 16;
                if (r < MV) { const float* xr = (r < TP ? xp + (size_t)r * D : xs + (size_t)(r - TP) * D) + col0; float* orow = X1 + (size_t)r * D + col0;
#pragma unroll
                    for (int bj = 0; bj < 2; ++bj) { const f32x4 a0 = __builtin_nontemporal_load((const f32x4*)(xr + bj * 128)), a1 = __builtin_nontemporal_load((const f32x4*)(xr + bj * 128 + 4));
                        *(f32x4*)(orow + bj * 128) = a0 + acc[ai][bj][m][0]; *(f32x4*)(orow + bj * 128 + 4) = a1 + acc[ai][bj][m][1]; } } }
    }
};
struct EpiResid2 {
    static constexpr bool PERM = true, AFTER_DRAIN = false;
    float* X1;
    __device__ __forceinline__ void operator()(const pg8::f32x4 (&acc)[2][2][4][2], const pg8::Unit& u, int wr, int wc, int fr, int fq) const {
        const int row0 = u.pm * 256 + wr * 64 + fr, col0 = u.pn * 256 + wc * 32 + 8 * fq;
#pragma unroll
        for (int ai = 0; ai < 2; ++ai)
#pragma unroll
            for (int m = 0; m < 4; ++m) { const int r = row0 + ai * 128 + m * 16;
                if (r < MV) { float* orow = X1 + (size_t)r * D + col0;
#pragma unroll
                    for (int bj = 0; bj < 2; ++bj) { const f32x4 a0 = *(const f32x4*)(orow + bj * 128), a1 = *(const f32x4*)(orow + bj * 128 + 4);
                        *(f32x4*)(orow + bj * 128) = a0 + acc[ai][bj][m][0]; *(f32x4*)(orow + bj * 128 + 4) = a1 + acc[ai][bj][m][1]; } } }
    }
};
struct EpiGlu {
    static constexpr bool PERM = true, AFTER_DRAIN = false;
    const bf16* YG; const bf16* UZ; const float* bglu; bf16* Y2;
    __device__ __forceinline__ void operator()(const pg8::f32x4 (&acc)[2][2][4][2], const pg8::Unit& u, int wr, int wc, int fr, int fq) const {
        const int row0 = u.pm * 256 + wr * 64 + fr, col0 = u.pn * 256 + wc * 32 + 8 * fq;
#pragma unroll
        for (int bj = 0; bj < 2; ++bj) { const int c = col0 + bj * 128; const f32x4 b0 = *(const f32x4*)(bglu + c), b1 = *(const f32x4*)(bglu + c + 4);
#pragma unroll
            for (int ai = 0; ai < 2; ++ai)
#pragma unroll
                for (int m = 0; m < 4; ++m) { const size_t r = (size_t)(row0 + ai * 128 + m * 16);
                    const v4u yv = *(const v4u*)(YG + r * E + c), zv = __builtin_nontemporal_load((const v4u*)(UZ + r * NZ + E + c));
                    const f32x4 g0 = acc[ai][bj][m][0] + b0, g1 = acc[ai][bj][m][1] + b1;
                    float o[8];
                    o[0] = lo_bf(yv.x) * sigmoidf_(g0[0]) * siluf_(lo_bf(zv.x)); o[1] = hi_bf(yv.x) * sigmoidf_(g0[1]) * siluf_(hi_bf(zv.x));
                    o[2] = lo_bf(yv.y) * sigmoidf_(g0[2]) * siluf_(lo_bf(zv.y)); o[3] = hi_bf(yv.y) * sigmoidf_(g0[3]) * siluf_(hi_bf(zv.y));
                    o[4] = lo_bf(yv.z) * sigmoidf_(g1[0]) * siluf_(lo_bf(zv.z)); o[5] = hi_bf(yv.z) * sigmoidf_(g1[1]) * siluf_(hi_bf(zv.z));
                    o[6] = lo_bf(yv.w) * sigmoidf_(g1[2]) * siluf_(lo_bf(zv.w)); o[7] = hi_bf(yv.w) * sigmoidf_(g1[3]) * siluf_(hi_bf(zv.w));
                    v4u w; w.x = pk2(o[0], o[1]); w.y = pk2(o[2], o[3]); w.z = pk2(o[4], o[5]); w.w = pk2(o[6], o[7]);
                    *(v4u*)(Y2 + r * E + c) = w; } }
    }
};

template <bool NTS = false>
__device__ __forceinline__ void p0_transpose_item(const float* W, int K, int N, bf16* WT, LAS float* scr, int item, int lane) {
    const int nblk = N / 32, kb = item / nblk, nb = item % nblk, k0 = 64 * kb, n0 = 32 * nb;
#pragma unroll 8
    for (int i = 0; i < 32; ++i) { const int kk = 2 * i + (lane >> 5); scr[kk * 33 + (lane & 31)] = __builtin_nontemporal_load(W + (size_t)(k0 + kk) * N + n0 + (lane & 31)); }
    LDS_WAIT(); asm volatile("" ::: "memory");
    const int c = lane & 7;
#pragma unroll
    for (int j = 0; j < 4; ++j) { const int n = (lane >> 3) + 8 * j; const LAS float* s = scr + (8 * c) * 33 + n;
        v4u o; o.x = pk2(s[0 * 33], s[1 * 33]); o.y = pk2(s[2 * 33], s[3 * 33]); o.z = pk2(s[4 * 33], s[5 * 33]); o.w = pk2(s[6 * 33], s[7 * 33]);
        if (NTS) __builtin_nontemporal_store(o, (v4u*)(WT + (size_t)(n0 + n) * K + k0 + 8 * c)); else *(v4u*)(WT + (size_t)(n0 + n) * K + k0 + 8 * c) = o; }
    LDS_WAIT(); asm volatile("" ::: "memory");
}
template <bool NT = false>
__device__ __forceinline__ void rms_row_bf16(const float* xrow, const float* g, bf16* orow, int lane) {
    const f32x4* xr = (const f32x4*)xrow + lane; f32x4 v[8]; float s = 0.f;
#pragma unroll
    for (int j = 0; j < 8; ++j) { v[j] = NT ? __builtin_nontemporal_load(xr + 64 * j) : xr[64 * j]; s += (v[j].x * v[j].x + v[j].y * v[j].y) + (v[j].z * v[j].z + v[j].w * v[j].w); }
    const float rs = 1.f / sqrtf(wave_sum(s) * (1.f / D) + RMS_EPS);
    const f32x4* gr = (const f32x4*)g + lane; v2u* o8 = (v2u*)orow + lane;
#pragma unroll
    for (int j = 0; j < 8; ++j) { const f32x4 gv = gr[64 * j]; v2u o; o.x = pk2(v[j].x * rs * gv.x, v[j].y * rs * gv.y); o.y = pk2(v[j].z * rs * gv.z, v[j].w * rs * gv.w); o8[64 * j] = o; }
}
__device__ __forceinline__ void rms_row_f32(const float* xrow, const float* g, float* orow, int lane) {
    const f32x4* xr = (const f32x4*)xrow + lane; f32x4 v[8]; float s = 0.f;
#pragma unroll
    for (int j = 0; j < 8; ++j) { v[j] = __builtin_nontemporal_load(xr + 64 * j); s += (v[j].x * v[j].x + v[j].y * v[j].y) + (v[j].z * v[j].z + v[j].w * v[j].w); }
    const float rs = 1.f / sqrtf(wave_sum(s) * (1.f / D) + RMS_EPS);
    const f32x4* gr = (const f32x4*)g + lane; f32x4* o = (f32x4*)orow + lane;
#pragma unroll
    for (int j = 0; j < 8; ++j) { const f32x4 gv = gr[64 * j]; __builtin_nontemporal_store(v[j] * rs * gv, o + 64 * j); }
}
__device__ __forceinline__ void phase0(const Ctx& C, LAS unsigned char* lds) {
    const int tid = fresh_tid(), lane = tid & 63, wave = tid >> 6;
    const int gw = blockIdx.x * 8 + wave, NGW = gridDim.x * 8;
    LAS float* scr = (LAS float*)(lds + wave * 16384);
    constexpr int I1 = (D / 64) * (N1 / 32), I2 = (E / 64) * (D / 32), I3 = (D / 64) * (NZ / 32), I4 = (E / 64) * (E / 32), I5 = I2, NIT = I1 + I2 + I3 + I4 + I5;
    for (int it = gw; it < NIT; it += NGW) {
        int r = it;
        if (r < I1) { p0_transpose_item(C.wing(), D, N1, C.WT1(), scr, r, lane); continue; } r -= I1;
        if (r < I2) { p0_transpose_item<true>(C.woutg(), E, D, C.WT2(), scr, r, lane); continue; } r -= I2;
        if (r < I3) { p0_transpose_item<true>(C.wins(), D, NZ, C.WT3(), scr, r, lane); continue; } r -= I3;
        if (r < I4) { p0_transpose_item<true>(C.wglu(), E, E, C.WT4(), scr, r, lane); continue; } r -= I4;
        p0_transpose_item<true>(C.wouts(), E, D, C.WT5(), scr, r, lane);
    }
    const int gt = blockIdx.x * 512 + tid, NGT = gridDim.x * 512;
    {
        v4u* z = (v4u*)(C.WT1() + (size_t)N1 * D); const v4u zero = {0u, 0u, 0u, 0u};
        for (int i = gt; i < (N1P - N1) * D / 8; i += NGT) z[i] = zero;
    }
    for (int m = gw; m < MP; m += NGW) {
        if (m < MV) rms_row_bf16<true>(m < TP ? C.xp() + (size_t)m * D : C.xs() + (size_t)(m - TP) * D, C.ng(), C.H() + (size_t)m * D, lane);
        else { v4u* o = (v4u*)(C.H() + (size_t)m * D); const v4u zero = {0u, 0u, 0u, 0u};
#pragma unroll
            for (int j = 0; j < 4; ++j) o[lane + 64 * j] = zero; }
    }
    if (gt < 256 * 64) {
        const int g = gt >> 6, p = gt & 63;
        const float lr = fminf(C.lre()[gt], -1e-4f), li = C.lim()[gt], dt = expf(C.logdt()[g]);
        const float mag = expf(lr * dt), ar = mag * cosf(li * dt), ai = mag * sinf(li * dt);
        const float den = lr * lr + li * li, xr = ar - 1.f, fr = (xr * lr + ai * li) / den, fi = (ai * lr - xr * li) / den;
        C.AR()[gt] = ar; C.AI()[gt] = ai;
        const float* br = C.bre() + (size_t)gt * 16; const float* bi = C.bim() + (size_t)gt * 16;
        bf16* o_re = C.BBT() + ((size_t)g * 128 + p) * 16; bf16* o_im = C.BBT() + ((size_t)g * 128 + 64 + p) * 16;
#pragma unroll
        for (int c = 0; c < 16; ++c) { const float b_r = br[c], b_i = bi[c]; o_re[c] = f2bf(fr * b_r - fi * b_i); o_im[c] = f2bf(fr * b_i + fi * b_r); }
#pragma unroll
        for (int c = 0; c < 16; ++c) { const size_t ci = ((size_t)g * 16 + c) * 64 + p; bf16* cm = C.CMT() + ((size_t)g * 16 + c) * 128;
            *(unsigned*)(cm + 2 * p) = pk2(C.cre()[ci], -C.cim()[ci]); }
    }
    {
        const f32x4* src = (const f32x4*)C.xs(); f32x4* dst = (f32x4*)(C.X1() + (size_t)TP * D);
        for (int i = gt; i < NSMP * D / 4; i += NGT) dst[i] = src[i];
    }
    {
        const f32x4* src = (const f32x4*)C.cs(); f32x4* dst = (f32x4*)(C.out() + O_CONVS);
        for (int i = gt; i < NSMP * 2 * 2048; i += NGT) { const int b = i / 4096, rem = i % 4096, r = rem / 2048, c4 = rem % 2048;
            dst[((size_t)b * 3 + r) * 2048 + c4] = src[((size_t)b * 3 + r + 1) * 2048 + c4]; }
    }
}

template <int CB, int K, class F>
__device__ __forceinline__ void skinny_wave(const bf16* A, int lda, const bf16* Bt, int lane, int rot, F&& epi) {
    const int i16 = lane & 15, q4 = lane >> 4;
    const bf16* ap = A + (size_t)i16 * lda + 8 * q4;
    const bf16* bp = Bt + (size_t)i16 * K + 8 * q4;
    f32x4 acc[CB];
#pragma unroll
    for (int j = 0; j < CB; ++j) acc[j] = (f32x4){0.f, 0.f, 0.f, 0.f};
    constexpr int U = CB == 1 ? 8 : 4;
    constexpr int nst = K / (32 * U); const int kofs = (rot * 32 * U) & (K - 1);
    bf16x8 a[2][U], b[2][CB][U];
#define SK_ISSUE(buf, st) do { const int k_ = (((st) < nst ? (st) : nst - 1) * 32 * U + kofs) & (K - 1); _Pragma("unroll") for (int u = 0; u < U; ++u) { a[buf][u] = *(const bf16x8*)(ap + k_ + 32 * u); \
        _Pragma("unroll") for (int j = 0; j < CB; ++j) b[buf][j][u] = *(const bf16x8*)(bp + (size_t)(16 * j) * K + k_ + 32 * u); } } while (0)
#define SK_MMA(buf) do { _Pragma("unroll") for (int u = 0; u < U; ++u) _Pragma("unroll") for (int j = 0; j < CB; ++j) acc[j] = __builtin_amdgcn_mfma_f32_16x16x32_bf16(b[buf][j][u], a[buf][u], acc[j], 0, 0, 0); } while (0)
    SK_ISSUE(0, 0);
#pragma unroll
    for (int st = 0; st < nst; st += 2) {
        SK_ISSUE(1, st + 1); __builtin_amdgcn_sched_barrier(0); SK_MMA(0); __builtin_amdgcn_sched_barrier(0);
        SK_ISSUE(0, st + 2); __builtin_amdgcn_sched_barrier(0); SK_MMA(1); __builtin_amdgcn_sched_barrier(0);
    }
#undef SK_ISSUE
#undef SK_MMA
#pragma unroll
    for (int j = 0; j < CB; ++j) epi(j, acc[j]);
}
template <int CBT, int CBW, int K, int LDB, class F>
__device__ __forceinline__ void skinny_wg(const bf16* A, int lda, const bf16* Bt, LAS unsigned char* lds, int tid, int jb, int rot, F&& epi) {
    constexpr int U = 8, SK = 32 * U, nst = K / SK, BPITCH = 528, BUFB = CBT * 16 * BPITCH;
    const int lane = tid & 63, i16 = lane & 15, q4 = lane >> 4;
    const bf16* ap = A + (size_t)i16 * lda + 8 * q4;
    const bf16* bg = Bt + (size_t)(tid >> 5) * LDB + (tid & 31) * 8;
    const int bl = (tid >> 5) * BPITCH + (tid & 31) * 16, kofs = (rot * SK) & (K - 1);
    const LAS unsigned char* br = lds + (jb * 16 + i16) * BPITCH + 16 * q4;
    f32x4 acc[CBW];
#pragma unroll
    for (int j = 0; j < CBW; ++j) acc[j] = (f32x4){0.f, 0.f, 0.f, 0.f};
    bf16x8 a[2][U]; v4u breg[CBT];
#define SKG_LOAD(buf, st) do { const int k_ = (((st) < nst ? (st) : nst - 1) * SK + kofs) & (K - 1); \
        _Pragma("unroll") for (int j = 0; j < CBT; ++j) breg[j] = *(const v4u*)(bg + (size_t)(16 * j) * LDB + k_); \
        _Pragma("unroll") for (int u = 0; u < U; ++u) a[buf][u] = *(const bf16x8*)(ap + k_ + 32 * u); } while (0)
    SKG_LOAD(0, 0);
#pragma unroll
    for (int st = 0; st < nst; ++st) {
        const int cb = st & 1;
#pragma unroll
        for (int j = 0; j < CBT; ++j) *(LAS v4u*)(lds + cb * BUFB + j * 16 * BPITCH + bl) = breg[j];
        SKG_LOAD(cb ^ 1, st + 1);
        BAR_LDS();
#pragma unroll
        for (int u = 0; u < U; ++u)
#pragma unroll
            for (int j = 0; j < CBW; ++j) acc[j] = __builtin_amdgcn_mfma_f32_16x16x32_bf16(*(const LAS bf16x8*)(br + cb * BUFB + j * 16 * BPITCH + 64 * u), a[cb][u], acc[j], 0, 0, 0);
    }
#undef SKG_LOAD
#pragma unroll
    for (int j = 0; j < CBW; ++j) epi(j, acc[j]);
}
__device__ __forceinline__ v2u pk4(const f32x4 v) { v2u w; w.x = pk2(v[0], v[1]); w.y = pk2(v[2], v[3]); return w; }

__device__ __forceinline__ bf16x8 afrag(const LAS unsigned char* p) {
    const v2u lo = *(const LAS v2u*)p, hi = *(const LAS v2u*)(p + 16); const v4u r = {lo.x, lo.y, hi.x, hi.y}; return __builtin_bit_cast(bf16x8, r);
}
__device__ __forceinline__ bf16x8 pack_half(const f32x16& X, int sub) {
    v4u r; r.x = pk2(X[8 * sub], X[8 * sub + 1]); r.y = pk2(X[8 * sub + 2], X[8 * sub + 3]); r.z = pk2(X[8 * sub + 4], X[8 * sub + 5]); r.w = pk2(X[8 * sub + 6], X[8 * sub + 7]);
    return __builtin_bit_cast(bf16x8, r);
}
constexpr int PQ_QL = 0, PQ_KL = 17408, PQ_KT = 34816, PQ_VT = 53248, PQ_KK = 90112, PQ_QK = 107520, PQ_LS0 = 124928, PQ_MISC = 142336;
constexpr int QL_PITCH = 272, KT_PITCH = 144, TB_PITCH = 136, KK_PITCH = 68;
__device__ __forceinline__ void gdn_prep_load(const Ctx& C, int unit, int tid, unsigned (&raw)[35], unsigned (&rab)[2]) {
    const int n = unit & 31, hq = (unit >> 5) & 15, b = unit >> 9, tensor = tid >> 7, cp = tid & 63, rh = (tid >> 6) & 1, lane = tid & 63;
    const size_t m0 = (size_t)b * SEQ + (size_t)n * 64;
    const int cidx = (tensor == 0 ? hq * 128 : tensor == 1 ? 2048 + hq * 128 : 4096 + (2 * hq + tensor - 2) * 128) + 2 * cp;
    const bf16* pc = C.P1() + (m0 + rh * 32) * N1P + cidx;
    const bool halo = n > 0 || rh > 0;
#pragma unroll
    for (int i = 0; i < 3; ++i) raw[i] = halo ? *(const unsigned*)(pc - (3 - i) * (ptrdiff_t)N1P) : 0u;
#pragma unroll
    for (int i = 0; i < 32; ++i) raw[3 + i] = *(const unsigned*)(pc + (size_t)i * N1P);
    if (tid < 128) { const bf16* pr = C.P1() + (m0 + lane) * N1P; const int hvw = 2 * hq + (tid >> 6); rab[0] = pr[OFF_A + hvw]; rab[1] = pr[OFF_B + hvw]; }
}
__device__ __forceinline__ void gdn_prep_unit(const Ctx& C, LAS unsigned char* lds, int unit, int next_unit, int tid_in, unsigned (&raw)[35], unsigned (&rab)[2]) {
    int tid = tid_in; asm volatile("" : "+v"(tid));
    const int lane = tid & 63, wave = __builtin_amdgcn_readfirstlane(tid >> 6);
    const int n = unit & 31, hq = (unit >> 5) & 15, b = unit >> 9;
    const int tensor = tid >> 7, ch = tid & 127;
    const size_t m0 = (size_t)b * SEQ + (size_t)n * 64;
    LAS float* KKs = (LAS float*)(lds + PQ_KK); LAS float* QKs = (LAS float*)(lds + PQ_QK); LAS float* Ls0 = (LAS float*)(lds + PQ_LS0);
    LAS float* gcS = (LAS float*)(lds + PQ_MISC); LAS float* betaS = gcS + 128; LAS float* rnq = gcS + 256; LAS float* rnk = gcS + 320;
    LAS float* f1 = gcS + 384;
    if (wave < 2) {
        const int hvw = 2 * hq + wave;
        const float av = bf2f((unsigned short)rab[0]), bv = bf2f((unsigned short)rab[1]);
        const float xx = av + C.dtb()[hvw]; const float sp = xx > 20.f ? xx : log1pf(__expf(xx));
        float g = -__expf(C.alog()[hvw]) * sp;
#pragma unroll
        for (int o = 1; o < 64; o <<= 1) { const float t = __shfl_up(g, o); if (lane >= o) g += t; }
        gcS[wave * 64 + lane] = g; betaS[wave * 64 + lane] = sigmoidf_(bv);
    }
    const int cp = tid & 63, rh = (tid >> 6) & 1;
    float xa[32], xb[32];
    {
        const int cidx = (tensor == 0 ? hq * 128 : tensor == 1 ? 2048 + hq * 128 : 4096 + (2 * hq + tensor - 2) * 128) + 2 * cp;
        const float* cw = C.convw() + cidx;
        const f32x2_t w0 = *(const f32x2_t*)cw, w1 = *(const f32x2_t*)(cw + 8192), w2 = *(const f32x2_t*)(cw + 2 * 8192), w3 = *(const f32x2_t*)(cw + 3 * 8192);
        const unsigned p3 = raw[0], p2 = raw[1], p1 = raw[2];
        float a3 = lo_bf(p3), a2 = lo_bf(p2), a1 = lo_bf(p1), b3 = hi_bf(p3), b2 = hi_bf(p2), b1 = hi_bf(p1);
#pragma unroll
        for (int i = 0; i < 32; ++i) { const unsigned pv = raw[3 + i]; const float ai = lo_bf(pv), bi = hi_bf(pv);
            xa[i] = siluf_(w0.x * a3 + w1.x * a2 + w2.x * a1 + w3.x * ai); xb[i] = siluf_(w0.y * b3 + w1.y * b2 + w2.y * b1 + w3.y * bi);
            a3 = a2; a2 = a1; a1 = ai; b3 = b2; b2 = b1; b1 = bi; }
        if (tensor < 2) {
            LAS unsigned* dst = (LAS unsigned*)(lds + (tensor ? PQ_KL : PQ_QL) + (rh * 32) * QL_PITCH) + cp;
#pragma unroll
            for (int i = 0; i < 32; ++i) dst[i * (QL_PITCH / 4)] = pk2(xa[i], xb[i]);
            if (tensor == 1) { LAS v4u* kta = (LAS v4u*)(lds + PQ_KT + (2 * cp) * KT_PITCH + rh * 64); LAS v4u* ktb = (LAS v4u*)(lds + PQ_KT + (2 * cp + 1) * KT_PITCH + rh * 64);
#pragma unroll
                for (int q = 0; q < 4; ++q) { v4u w; w.x = pk2(xa[8 * q], xa[8 * q + 1]); w.y = pk2(xa[8 * q + 2], xa[8 * q + 3]); w.z = pk2(xa[8 * q + 4], xa[8 * q + 5]); w.w = pk2(xa[8 * q + 6], xa[8 * q + 7]); kta[q] = w;
                    v4u u; u.x = pk2(xb[8 * q], xb[8 * q + 1]); u.y = pk2(xb[8 * q + 2], xb[8 * q + 3]); u.z = pk2(xb[8 * q + 4], xb[8 * q + 5]); u.w = pk2(xb[8 * q + 6], xb[8 * q + 7]); ktb[q] = u; } }
        }
    }
    BAR_LDS();
    if (tensor >= 2) {
        const int e = tensor - 2; const LAS float* be = betaS + e * 64 + rh * 32;
        LAS v4u* vta = (LAS v4u*)(lds + PQ_VT + (e * 128 + 2 * cp) * KT_PITCH + rh * 64); LAS v4u* vtb = (LAS v4u*)(lds + PQ_VT + (e * 128 + 2 * cp + 1) * KT_PITCH + rh * 64);
#pragma unroll
        for (int q = 0; q < 4; ++q) { v4u w; w.x = pk2(xa[8 * q] * be[8 * q], xa[8 * q + 1] * be[8 * q + 1]); w.y = pk2(xa[8 * q + 2] * be[8 * q + 2], xa[8 * q + 3] * be[8 * q + 3]);
            w.z = pk2(xa[8 * q + 4] * be[8 * q + 4], xa[8 * q + 5] * be[8 * q + 5]); w.w = pk2(xa[8 * q + 6] * be[8 * q + 6], xa[8 * q + 7] * be[8 * q + 7]); vta[q] = w;
            v4u u; u.x = pk2(xb[8 * q] * be[8 * q], xb[8 * q + 1] * be[8 * q + 1]); u.y = pk2(xb[8 * q + 2] * be[8 * q + 2], xb[8 * q + 3] * be[8 * q + 3]);
            u.z = pk2(xb[8 * q + 4] * be[8 * q + 4], xb[8 * q + 5] * be[8 * q + 5]); u.w = pk2(xb[8 * q + 6] * be[8 * q + 6], xb[8 * q + 7] * be[8 * q + 7]); vtb[q] = u; }
    }
    {
        const int mat = wave >> 2, ti = (wave >> 1) & 1, tj = wave & 1, c32 = lane & 31, h = lane >> 5;
        const LAS unsigned char* Ab = lds + (mat ? PQ_QL : PQ_KL) + (32 * ti + c32) * QL_PITCH + h * 16;
        const LAS unsigned char* Bb = lds + PQ_KL + (32 * tj + c32) * QL_PITCH + h * 16;
        f32x16 acc;
#pragma unroll
        for (int r = 0; r < 16; ++r) acc[r] = 0.f;
#pragma unroll
        for (int s = 0; s < 8; ++s) { const bf16x8 a = *(const LAS bf16x8*)(Ab + s * 32), bb = *(const LAS bf16x8*)(Bb + s * 32); acc = MFMA32(a, bb, acc); }
        LAS float* Ot = mat ? QKs : KKs;
#pragma unroll
        for (int r = 0; r < 16; ++r) { const int row = 32 * ti + (r & 3) + 8 * (r >> 2) + 4 * h; Ot[row * KK_PITCH + 32 * tj + c32] = acc[r]; }
        if (mat == 0 && ti == tj) {
#pragma unroll
            for (int r = 0; r < 16; ++r) if (((r & 3) + 8 * (r >> 2) + 4 * h) == c32) rnk[32 * ti + c32] = 1.f / sqrtf(acc[r] + 1e-6f);
        }
        if (wave < 2) {
            const LAS unsigned char* Qb = lds + PQ_QL + (32 * wave + c32) * QL_PITCH + h * 16;
            f32x16 qq;
#pragma unroll
            for (int r = 0; r < 16; ++r) qq[r] = 0.f;
#pragma unroll
            for (int s = 0; s < 8; ++s) { const bf16x8 a = *(const LAS bf16x8*)(Qb + s * 32); qq = MFMA32(a, a, qq); }
#pragma unroll
            for (int r = 0; r < 16; ++r) if (((r & 3) + 8 * (r >> 2) + 4 * h) == c32) rnq[32 * wave + c32] = 0.08838834764831845f / sqrtf(qq[r] + 1e-6f);
        }
    }
    BAR_LDS();
    if (tid < 128) { const int e = tid >> 6, i = tid & 63; const float gc = gcS[tid], gl = gcS[e * 64 + 63], eg = __expf(gc);
        f1[tid] = rnq[i] * eg; f1[128 + tid] = rnk[i] * __expf(gl - gc); f1[256 + tid] = betaS[tid] * rnk[i] * eg; }
    BAR_LDS();
    const LAS float* f2 = f1 + 128; const LAS float* f3 = f1 + 256;
    {
        unsigned char* rec0 = C.REC() + (size_t)((b * 32 + 2 * hq) * 32 + n) * REC_BYTES;
#pragma unroll
        for (int r = 0; r < 2; ++r) { const int it = tid + 512 * r, i = it >> 4, j0 = (it & 15) * 4;
            const f32x4 kk4 = *(const LAS f32x4*)(KKs + i * KK_PITCH + j0), qk4 = *(const LAS f32x4*)(QKs + i * KK_PITCH + j0);
            const float rki = rnk[i], rqi = rnq[i], g0i = gcS[i], g1i = gcS[64 + i], b0i = betaS[i], b1i = betaS[64 + i];
            f32x4 l0, l1; float a0[4], a1[4];
#pragma unroll
            for (int t = 0; t < 4; ++t) { const int j = j0 + t; const float rkj = rnk[j];
                const float kk = kk4[t] * rki * rkj, qk = qk4[t] * rqi * rkj, d0 = __expf(g0i - gcS[j]), d1 = __expf(g1i - gcS[64 + j]);
                l0[t] = j < i ? b0i * kk * d0 : 0.f; l1[t] = j < i ? b1i * kk * d1 : 0.f; a0[t] = j <= i ? qk * d0 : 0.f; a1[t] = j <= i ? qk * d1 : 0.f; }
            *(LAS f32x4*)(Ls0 + i * KK_PITCH + j0) = l0; *(LAS f32x4*)(KKs + i * KK_PITCH + j0) = l1;
            v2u w0; w0.x = pk2(a0[0], a0[1]); w0.y = pk2(a0[2], a0[3]); v2u w1; w1.x = pk2(a1[0], a1[1]); w1.y = pk2(a1[2], a1[3]);
            *(v2u*)(rec0 + REC_AT + (i * 64 + j0) * 2) = w0; *(v2u*)(rec0 + (size_t)32 * REC_BYTES + REC_AT + (i * 64 + j0) * 2) = w1; }
#pragma unroll
        for (int r = 0; r < 4; ++r) { const int it = tid + 512 * r, e = it >> 10, rem = it & 1023, i = rem >> 4, d8 = rem & 15;
            const v4u qv = *(const LAS v4u*)(lds + PQ_QL + i * QL_PITCH + d8 * 16); const float sc = f1[e * 64 + i];
            v4u w; w.x = pk2(lo_bf(qv.x) * sc, hi_bf(qv.x) * sc); w.y = pk2(lo_bf(qv.y) * sc, hi_bf(qv.y) * sc); w.z = pk2(lo_bf(qv.z) * sc, hi_bf(qv.z) * sc); w.w = pk2(lo_bf(qv.w) * sc, hi_bf(qv.w) * sc);
            *(v4u*)(rec0 + (size_t)e * 32 * REC_BYTES + REC_QD + i * 256 + d8 * 16) = w; }
#pragma unroll
        for (int r = 0; r < 4; ++r) { const int it = tid + 512 * r, e = it >> 10, rem = it & 1023, d = rem >> 3, i8 = rem & 7;
            const v4u kv = *(const LAS v4u*)(lds + PQ_KT + d * KT_PITCH + i8 * 16); const LAS float* sc = f2 + e * 64 + 8 * i8;
            v4u w; w.x = pk2(lo_bf(kv.x) * sc[0], hi_bf(kv.x) * sc[1]); w.y = pk2(lo_bf(kv.y) * sc[2], hi_bf(kv.y) * sc[3]); w.z = pk2(lo_bf(kv.z) * sc[4], hi_bf(kv.z) * sc[5]); w.w = pk2(lo_bf(kv.w) * sc[6], hi_bf(kv.w) * sc[7]);
            *(v4u*)(rec0 + (size_t)e * 32 * REC_BYTES + REC_KDT + d * 128 + i8 * 16) = w; }
        if (tid < 2) C.GL()[(b * 32 + 2 * hq + tid) * 32 + n] = __expf(gcS[tid * 64 + 63]);
    }
    BAR_LDS();
    if (next_unit >= 0) gdn_prep_load(C, next_unit, tid, raw, rab);
    if (wave < 2) {
        const int c32 = lane & 31, hb = lane >> 5;
        const LAS float* Lm = wave ? KKs : Ls0;
        const LAS float* L = Lm + (hb * 32) * KK_PITCH + hb * 32;
        float t[32];
#pragma unroll
        for (int i = 0; i < 32; ++i) {
            float s0 = (i == c32) ? 1.f : 0.f, s1 = 0.f, s2 = 0.f, s3 = 0.f;
#pragma unroll
            for (int j4 = 0; j4 < (i + 3) / 4; ++j4) { const f32x4 l = *(const LAS f32x4*)(L + i * KK_PITCH + 4 * j4);
                if (4 * j4 + 0 < i) s0 -= l.x * t[4 * j4 + 0];
                if (4 * j4 + 1 < i) s1 -= l.y * t[4 * j4 + 1];
                if (4 * j4 + 2 < i) s2 -= l.z * t[4 * j4 + 2];
                if (4 * j4 + 3 < i) s3 -= l.w * t[4 * j4 + 3]; }
            t[i] = (s0 + s1) + (s2 + s3);
        }
        const float sc = f3[wave * 64 + lane];
        LAS unsigned char* T1base = lds + PQ_QL + wave * 8704; LAS unsigned char* T2base = lds + PQ_QK + wave * 8704;
        {
            LAS bf16* T1 = (LAS bf16*)(T1base + (hb * 32) * TB_PITCH) + lane; LAS bf16* T2 = (LAS bf16*)(T2base + (hb * 32) * TB_PITCH) + lane;
#pragma unroll
            for (int i = 0; i < 32; ++i) { T1[i * (TB_PITCH / 2)] = f2bf(t[i]); T2[i * (TB_PITCH / 2)] = f2bf(t[i] * sc); }
            if (hb) { LAS bf16* Z1 = (LAS bf16*)T1base + lane; LAS bf16* Z2 = (LAS bf16*)T2base + lane;
#pragma unroll
                for (int i = 0; i < 32; ++i) { Z1[i * (TB_PITCH / 2)] = 0; Z2[i * (TB_PITCH / 2)] = 0; } }
        }
        if (!hb) { LAS v4u* tt = (LAS v4u*)((LAS unsigned char*)Lm + c32 * (KK_PITCH * 4) + 128);
#pragma unroll
            for (int q = 0; q < 4; ++q) { v4u w; w.x = pk2(t[8 * q], t[8 * q + 1]); w.y = pk2(t[8 * q + 2], t[8 * q + 3]); w.z = pk2(t[8 * q + 4], t[8 * q + 5]); w.w = pk2(t[8 * q + 6], t[8 * q + 7]); tt[q] = w; } }
        f32x16 M;
#pragma unroll
        for (int r = 0; r < 16; ++r) M[r] = 0.f;
#pragma unroll
        for (int s2 = 0; s2 < 2; ++s2) {
            const LAS f32x4* lp = (const LAS f32x4*)(Lm + (32 + c32) * KK_PITCH + 16 * s2 + 8 * hb); const f32x4 la = lp[0], lb = lp[1];
            v4u av; av.x = pk2(la.x, la.y); av.y = pk2(la.z, la.w); av.z = pk2(lb.x, lb.y); av.w = pk2(lb.z, lb.w);
            const bf16x8 bv = *(const LAS bf16x8*)((const LAS unsigned char*)Lm + c32 * (KK_PITCH * 4) + 128 + (16 * s2 + 8 * hb) * 2);
            M = MFMA32(__builtin_bit_cast(bf16x8, av), bv, M); }
        f32x16 T21;
#pragma unroll
        for (int r = 0; r < 16; ++r) T21[r] = 0.f;
#pragma unroll
        for (int s2 = 0; s2 < 2; ++s2) T21 = MFMA32(afrag(T1base + (32 + c32) * TB_PITCH + (32 + 16 * s2 + 4 * hb) * 2), pack_half(M, s2), T21);
        {   const float sc21 = f3[wave * 64 + c32];
            LAS bf16* T1 = (LAS bf16*)(T1base + (32 + 4 * hb) * TB_PITCH) + c32; LAS bf16* T2 = (LAS bf16*)(T2base + (32 + 4 * hb) * TB_PITCH) + c32;
#pragma unroll
            for (int r = 0; r < 16; ++r) { const int ro = ((r & 3) + 8 * (r >> 2)) * (TB_PITCH / 2); T1[ro] = f2bf(-T21[r]); T2[ro] = f2bf(-T21[r] * sc21); } }
    }
    BAR_LDS();
    {
        const int e = wave >> 2, ct = wave & 3, c32 = lane & 31, h = lane >> 5;
        unsigned char* rec = C.REC() + (size_t)((b * 32 + 2 * hq + e) * 32 + n) * REC_BYTES;
        const LAS unsigned char* Bv = lds + PQ_VT + (e * 128 + 32 * ct + c32) * KT_PITCH + h * 16;
        const LAS unsigned char* Bk = lds + PQ_KT + (32 * ct + c32) * KT_PITCH + h * 16;
#pragma unroll
        for (int t = 0; t < 2; ++t) {
            const LAS unsigned char* A1 = lds + PQ_QL + e * 8704 + (32 * t + c32) * TB_PITCH + h * 16;
            const LAS unsigned char* A2 = lds + PQ_QK + e * 8704 + (32 * t + c32) * TB_PITCH + h * 16;
            f32x16 au, aw;
#pragma unroll
            for (int r = 0; r < 16; ++r) { au[r] = 0.f; aw[r] = 0.f; }
#pragma unroll
            for (int s = 0; s < 4; ++s) {
                const v2u a1l = *(const LAS v2u*)(A1 + s * 32), a1h = *(const LAS v2u*)(A1 + s * 32 + 8), a2l = *(const LAS v2u*)(A2 + s * 32), a2h = *(const LAS v2u*)(A2 + s * 32 + 8);
                const v4u a1 = {a1l.x, a1l.y, a1h.x, a1h.y}, a2 = {a2l.x, a2l.y, a2h.x, a2h.y};
                au = MFMA32(__builtin_bit_cast(bf16x8, a1), *(const LAS bf16x8*)(Bv + s * 32), au);
                aw = MFMA32(*(const LAS bf16x8*)(Bk + s * 32), __builtin_bit_cast(bf16x8, a2), aw); }
            unsigned char* ut = rec + REC_UT + (32 * ct + c32) * 128 + (32 * t + 4 * h) * 2;
#pragma unroll
            for (int g4 = 0; g4 < 4; ++g4) { v2u w; w.x = pk2(au[4 * g4], au[4 * g4 + 1]); w.y = pk2(au[4 * g4 + 2], au[4 * g4 + 3]); *(v2u*)(ut + 16 * g4) = w; }
            unsigned char* wn = rec + REC_WN + ((32 * t + c32) * 128 + 32 * ct + 4 * h) * 2;
#pragma unroll
            for (int g4 = 0; g4 < 4; ++g4) { v2u w; w.x = pk2(-aw[4 * g4], -aw[4 * g4 + 1]); w.y = pk2(-aw[4 * g4 + 2], -aw[4 * g4 + 3]); *(v2u*)(wn + 16 * g4) = w; }
        }
    }
    BAR_LDS();
}
__device__ __forceinline__ void phase2(const Ctx& C, LAS unsigned char* lds) {
    {   const int tid = fresh_tid(); unsigned raw[35], rab[2] = {0u, 0u};
        if ((int)blockIdx.x < NB * 16 * 32) gdn_prep_load(C, blockIdx.x, tid, raw, rab);
#pragma unroll 1
        for (int u = blockIdx.x; u < NB * 16 * 32; u += gridDim.x) { const int nu = u + (int)gridDim.x; gdn_prep_unit(C, lds, u, nu < NB * 16 * 32 ? nu : -1, tid, raw, rab); } }
    const int gt = blockIdx.x * 512 + fresh_tid(), NGT = gridDim.x * 512;
    for (int i = gt; i < (NB * 3 + NSMP) * 4096; i += NGT) { const int rr = i >> 12, c2 = i & 4095;
        size_t m; float* dst;
        if (rr < NB * 3) { const int b = rr / 3, r = rr % 3; m = (size_t)b * SEQ + SEQ - 3 + r; dst = C.out() + O_CONVP + (size_t)rr * 8192; }
        else { const int b = rr - NB * 3; m = TP + b; dst = C.out() + O_CONVS + ((size_t)b * 3 + 2) * 8192; }
        const unsigned v = *(const unsigned*)(C.P1() + m * N1P + 2 * c2);
        f32x2_t o = {lo_bf(v), hi_bf(v)}; *(f32x2_t*)(dst + 2 * c2) = o; }
}

constexpr int SC_SLOT = 62464, SC_WNQD = 0, SC_ATK = 34816, SC_OBUF = 2 * SC_SLOT, SC_PITCH_A = 272, SC_PITCH_B = 144;
__device__ __forceinline__ void gdn_scan_unit(const Ctx& C, LAS unsigned char* lds, int bh) {
    const int tid = fresh_tid(), lane = tid & 63, wave = __builtin_amdgcn_readfirstlane(tid >> 6), c32 = lane & 31, h = lane >> 5;
    const int b = bh >> 5, hv = bh & 31;
    const unsigned char* rec0 = C.REC() + (size_t)bh * 32 * REC_BYTES;
    f32x16 S[4];
#pragma unroll
    for (int T = 0; T < 4; ++T)
#pragma unroll
        for (int r = 0; r < 16; ++r) S[T][r] = 0.f;
    const int lt = tid & 255;
    const int ldA = SC_WNQD + (lt >> 4) * SC_PITCH_A + (lt & 15) * 16, ldB = SC_ATK + (lt >> 3) * SC_PITCH_B + (lt & 7) * 16;
    if (wave >= 4) {
#pragma unroll
        for (int r = 0; r < 14; ++r) { const v4u v = *(const v4u*)(rec0 + 16 * lt + 4096 * r);
            *(LAS v4u*)(lds + (r < 8 ? ldA + r * 16 * SC_PITCH_A : ldB + (r - 8) * 32 * SC_PITCH_B)) = v; } }
    BAR_LDS();
    for (int n = 0; n < 32; ++n) {
        const unsigned char* rec = rec0 + (size_t)n * REC_BYTES;
        const LAS unsigned char* slot = lds + (n & 1) * SC_SLOT;
        const int ntok = tid >> 3, nseg = tid & 7; const size_t nm = (size_t)b * SEQ + n * 64 + ntok;
        const v4u* zp = (const v4u*)(C.P1() + nm * N1P + NZ + hv * 128 + nseg * 16); const v4u z0 = zp[0], z1 = zp[1];
        if (wave >= 4) {
            if (n < 31) { const unsigned char* nrec = rec + REC_BYTES; LAS unsigned char* ns = lds + ((n + 1) & 1) * SC_SLOT;
                v4u v[14];
#pragma unroll
                for (int r = 0; r < 14; ++r) v[r] = *(const v4u*)(nrec + 16 * lt + 4096 * r);
#pragma unroll
                for (int r = 0; r < 14; ++r) *(LAS v4u*)(ns + (r < 8 ? ldA + r * 16 * SC_PITCH_A : ldB + (r - 8) * 32 * SC_PITCH_B)) = v[r]; }
        } else {
            __builtin_amdgcn_s_setprio(1);
            const int dv = 32 * wave + c32;
            f32x16 V[2], O[2];
            {
                const unsigned char* ut = rec + REC_UT + dv * 128 + h * 8;
#pragma unroll
                for (int t = 0; t < 2; ++t)
#pragma unroll
                    for (int g4 = 0; g4 < 4; ++g4) { const v2u w = *(const v2u*)(ut + (32 * t + 8 * g4) * 2);
                        V[t][4 * g4 + 0] = lo_bf(w.x); V[t][4 * g4 + 1] = hi_bf(w.x); V[t][4 * g4 + 2] = lo_bf(w.y); V[t][4 * g4 + 3] = hi_bf(w.y); }
#pragma unroll
                for (int t = 0; t < 2; ++t)
#pragma unroll
                    for (int r = 0; r < 16; ++r) O[t][r] = 0.f;
            }
            const float gl = C.GL()[bh * 32 + n];
            const LAS unsigned char* aW = slot + SC_WNQD + c32 * SC_PITCH_A + h * 8;
            const LAS unsigned char* aK = slot + SC_ATK + c32 * SC_PITCH_B + h * 8;
#pragma unroll
            for (int s = 0; s < 8; ++s) { const bf16x8 sb = pack_half(S[s >> 1], s & 1);
                V[0] = MFMA32(afrag(aW + s * 32), sb, V[0]);
                V[1] = MFMA32(afrag(aW + 32 * SC_PITCH_A + s * 32), sb, V[1]);
                O[0] = MFMA32(afrag(aW + 64 * SC_PITCH_A + s * 32), sb, O[0]);
                O[1] = MFMA32(afrag(aW + 96 * SC_PITCH_A + s * 32), sb, O[1]); __builtin_amdgcn_sched_barrier(0); }
#pragma unroll
            for (int T = 0; T < 4; ++T) S[T] = S[T] * gl;
#pragma unroll
            for (int s = 0; s < 4; ++s) { const bf16x8 vb = pack_half(V[s >> 1], s & 1);
                O[0] = MFMA32(afrag(aK + s * 32), vb, O[0]);
                O[1] = MFMA32(afrag(aK + 32 * SC_PITCH_B + s * 32), vb, O[1]);
#pragma unroll
                for (int T = 0; T < 4; ++T) S[T] = MFMA32(afrag(aK + (64 + 32 * T) * SC_PITCH_B + s * 32), vb, S[T]);
                __builtin_amdgcn_sched_barrier(0); }
            LAS bf16* ob = (LAS bf16*)(lds + SC_OBUF) + dv;
#pragma unroll
            for (int t = 0; t < 2; ++t)
#pragma unroll
                for (int r = 0; r < 16; ++r) { const int tok = 32 * t + (r & 3) + 8 * (r >> 2) + 4 * h; ob[tok * (SC_PITCH_A / 2)] = f2bf(O[t][r]); }
            __builtin_amdgcn_s_setprio(0);
        }
        BAR_LDS();
        {
            const int tok = ntok, seg = nseg; const size_t m = nm;
            const LAS v4u* op = (const LAS v4u*)(lds + SC_OBUF + tok * SC_PITCH_A + seg * 32);
            const v4u o0 = op[0], o1 = op[1];
            float o[16] = {lo_bf(o0.x), hi_bf(o0.x), lo_bf(o0.y), hi_bf(o0.y), lo_bf(o0.z), hi_bf(o0.z), lo_bf(o0.w), hi_bf(o0.w),
                           lo_bf(o1.x), hi_bf(o1.x), lo_bf(o1.y), hi_bf(o1.y), lo_bf(o1.z), hi_bf(o1.z), lo_bf(o1.w), hi_bf(o1.w)};
            float ss = 0.f;
#pragma unroll
            for (int i = 0; i < 16; ++i) ss += o[i] * o[i];
            ss += __shfl_xor(ss, 1); ss += __shfl_xor(ss, 2); ss += __shfl_xor(ss, 4);
            const float rs = 1.f / sqrtf(ss * (1.f / 128.f) + RMS_EPS);
            const float z[16] = {lo_bf(z0.x), hi_bf(z0.x), lo_bf(z0.y), hi_bf(z0.y), lo_bf(z0.z), hi_bf(z0.z), lo_bf(z0.w), hi_bf(z0.w),
                                 lo_bf(z1.x), hi_bf(z1.x), lo_bf(z1.y), hi_bf(z1.y), lo_bf(z1.z), hi_bf(z1.z), lo_bf(z1.w), hi_bf(z1.w)};
            const float* gn = C.onorm() + seg * 16;
            float y[16];
#pragma unroll
            for (int i = 0; i < 16; ++i) y[i] = o[i] * rs * gn[i] * siluf_(z[i]);
            v4u w0, w1; w0.x = pk2(y[0], y[1]); w0.y = pk2(y[2], y[3]); w0.z = pk2(y[4], y[5]); w0.w = pk2(y[6], y[7]);
            w1.x = pk2(y[8], y[9]); w1.y = pk2(y[10], y[11]); w1.z = pk2(y[12], y[13]); w1.w = pk2(y[14], y[15]);
            v4u* og = (v4u*)(C.OG() + m * E + hv * 128 + seg * 16); og[0] = w0; og[1] = w1;
        }
        BAR_LDS();
    }
    if (wave < 4) {
        float* dp = C.out() + O_DELTAP + (size_t)bh * 16384 + 32 * wave + c32;
#pragma unroll
        for (int T = 0; T < 4; ++T)
#pragma unroll
            for (int r = 0; r < 16; ++r) { const int dk = 32 * T + (r & 3) + 8 * (r >> 2) + 4 * h; __builtin_nontemporal_store(S[T][r], dp + dk * 128); }
    }
}

__device__ __forceinline__ void gdn_sample_unit(const Ctx& C, LAS unsigned char* lds, int unit) {
    const int tid = fresh_tid(), lane = tid & 63, wave = tid >> 6;
    const int b = unit >> 5, hv = unit & 31, hq = hv >> 1; const size_t m = TP + b;
    LAS float* sv = (LAS float*)lds;
    LAS float* part = (LAS float*)(lds + 2048);
    LAS float* misc = (LAS float*)(lds + 2048 + 8192);
    const bf16* pr = C.P1() + m * N1P;
    const int dv4 = tid & 31, dk0 = tid >> 5;
    const f32x4* Sp = (const f32x4*)(C.ds() + (size_t)unit * 16384) + dv4;
    f32x4 S[8];
#pragma unroll
    for (int r = 0; r < 8; ++r) S[r] = __builtin_nontemporal_load(Sp + (dk0 + 16 * r) * 32);
    if (tid < 384) { const int tensor = tid >> 7, ch = tid & 127;
        const int cidx = tensor == 0 ? hq * 128 + ch : tensor == 1 ? 2048 + hq * 128 + ch : 4096 + hv * 128 + ch;
        const float* st = C.cs() + (size_t)b * 3 * 8192 + cidx;
        const float y = C.convw()[cidx] * st[0] + C.convw()[8192 + cidx] * st[8192] + C.convw()[2 * 8192 + cidx] * st[2 * 8192] + C.convw()[3 * 8192 + cidx] * bf2f(pr[cidx]);
        sv[tid] = siluf_(y); }
    BAR_LDS();
    if (wave < 2) { const float a0 = sv[wave * 128 + lane], a1 = sv[wave * 128 + 64 + lane]; float rn = 1.f / sqrtf(wave_sum(a0 * a0 + a1 * a1) + 1e-6f);
        if (wave == 0) rn *= 0.08838834764831845f;
        sv[wave * 128 + lane] = a0 * rn; sv[wave * 128 + 64 + lane] = a1 * rn; }
    BAR_LDS();
    if (wave == 0) { const float qk = wave_sum(sv[lane] * sv[128 + lane] + sv[64 + lane] * sv[192 + lane]); if (lane == 0) misc[0] = qk; }
    const float av = bf2f(pr[OFF_A + hv]), bv = bf2f(pr[OFF_B + hv]);
    const float xx = av + C.dtb()[hv]; const float sp = xx > 20.f ? xx : log1pf(__expf(xx));
    const float eg = __expf(-__expf(C.alog()[hv]) * sp), beta = sigmoidf_(bv);
    f32x4 ks = {0.f, 0.f, 0.f, 0.f}, qs = {0.f, 0.f, 0.f, 0.f};
#pragma unroll
    for (int r = 0; r < 8; ++r) { const float qd = sv[dk0 + 16 * r], kd = sv[128 + dk0 + 16 * r]; ks += S[r] * kd; qs += S[r] * qd; }
#pragma unroll
    for (int i = 0; i < 4; ++i) { ks[i] += __shfl_xor(ks[i], 32); qs[i] += __shfl_xor(qs[i], 32); }
    if (lane < 32) { *(LAS f32x4*)(part + wave * 128 + 4 * dv4) = ks; *(LAS f32x4*)(part + 1024 + wave * 128 + 4 * dv4) = qs; }
    BAR_LDS();
    ks = (f32x4){0.f, 0.f, 0.f, 0.f}; qs = ks;
#pragma unroll
    for (int w = 0; w < 8; ++w) { ks += *(const LAS f32x4*)(part + w * 128 + 4 * dv4); qs += *(const LAS f32x4*)(part + 1024 + w * 128 + 4 * dv4); }
    const f32x4 vv = *(const LAS f32x4*)(sv + 256 + 4 * dv4); const float qk = misc[0];
    const f32x4 vn = (vv - ks * eg) * beta;
    const f32x4 o = qs * eg + vn * qk;
    f32x4* So = (f32x4*)(C.out() + O_DELTAS + (size_t)unit * 16384) + dv4;
#pragma unroll
    for (int r = 0; r < 8; ++r) { const float kd = sv[128 + dk0 + 16 * r]; __builtin_nontemporal_store(S[r] * eg + vn * kd, So + (dk0 + 16 * r) * 32); }
    if (wave == 0) {
        float ss = o.x * o.x + o.y * o.y + o.z * o.z + o.w * o.w;
        ss += __shfl_xor(ss, 1); ss += __shfl_xor(ss, 2); ss += __shfl_xor(ss, 4); ss += __shfl_xor(ss, 8); ss += __shfl_xor(ss, 16);
        const float rs = 1.f / sqrtf(ss * (1.f / 128.f) + RMS_EPS);
        if (lane < 32) { const v2u zv = *(const v2u*)(pr + NZ + hv * 128 + 4 * dv4); const f32x4 gn = *(const f32x4*)(C.onorm() + 4 * dv4);
            v2u w; w.x = pk2(o.x * rs * gn.x * siluf_(lo_bf(zv.x)), o.y * rs * gn.y * siluf_(hi_bf(zv.x)));
            w.y = pk2(o.z * rs * gn.z * siluf_(lo_bf(zv.y)), o.w * rs * gn.w * siluf_(hi_bf(zv.y)));
            *(v2u*)(C.OG() + m * E + hv * 128 + 4 * dv4) = w; } }
    BAR_LDS();
}
__device__ __forceinline__ void phase3(const Ctx& C, LAS unsigned char* lds) {
    for (int bh = blockIdx.x; bh < NB * 32; bh += gridDim.x) gdn_scan_unit(C, lds, bh);
    LAS int* qslot = (LAS int*)(lds + 16384); const int qt = fresh_tid();
    for (;;) {
        if (qt == 0) *qslot = (int)atomicAdd(C.ctl() + 0, 1u);
        BAR_LDS();
        const int u = *qslot;
        BAR_LDS();
        if (u >= NSMP * 32) break;
        gdn_sample_unit(C, lds, u);
    }
}

constexpr int SS_SLOT = 36864, SS_HS = 17408, SS_HSB = 8704, SS_UL = 34816, SS_HS_PITCH = 272, SS_BU_PITCH = 272;
template <bool SAMPLE>
__device__ __forceinline__ void ssm_round(const Ctx& C, LAS unsigned char* lds, int ubase, int tid) {
    const int lane = tid & 63, wave = __builtin_amdgcn_readfirstlane(tid >> 6), slot = wave & 3, role = wave >> 2;
    const int u = ubase + slot, seq = u >> 8, g = u & 255;
    LAS unsigned char* wl = lds + slot * SS_SLOT;
    const int c32 = lane & 31, h = lane >> 5, c16 = lane & 15, q4 = lane >> 4;
    constexpr int nchunk = SAMPLE ? NSMP / 32 : SEQ / 32;
    const size_t mbase = SAMPLE ? (size_t)TP : (size_t)seq * SEQ;
    if (role == 0) {
        bf16x8 bb[4];
#pragma unroll
        for (int j = 0; j < 4; ++j) bb[j] = *(const bf16x8*)(C.BBT() + ((size_t)g * 128 + 32 * j + c32) * 16 + 8 * h);
        const float ar = C.AR()[g * 64 + lane], ai = C.AI()[g * 64 + lane];
        const f32x2_t A2 = {ar, ar}, B2 = {-ai, ai}; f32x2_t h2 = {0.f, 0.f};
        __builtin_amdgcn_s_setprio(1);
        const bf16* up = C.UZ() + (mbase + c32) * NZ + g * 16 + 8 * h;
        bf16x8 ring[4];
#pragma unroll
        for (int i = 0; i < 4; ++i) ring[i] = __builtin_nontemporal_load((const bf16x8*)(up + (size_t)i * 32 * NZ));
#pragma unroll 1
        for (int ck0 = 0; ck0 < nchunk; ck0 += 4) {
#pragma unroll
            for (int ci = 0; ci < 4; ++ci) { const int ck = ck0 + ci;
                const bf16x8 ua = ring[ci];
                ring[ci] = __builtin_nontemporal_load((const bf16x8*)(up + (size_t)(ck + 4 < nchunk ? ck + 4 : nchunk - 1) * 32 * NZ));
                LAS unsigned char* HS = wl + SS_HS + (ck & 1) * SS_HSB;
                *(LAS bf16x8*)(wl + SS_UL + (ck & 1) * 1024 + c32 * 32 + h * 16) = ua;
#pragma unroll
                for (int j2 = 0; j2 < 2; ++j2) { f32x16 aR, aI;
#pragma unroll
                    for (int r = 0; r < 16; ++r) { aR[r] = 0.f; aI[r] = 0.f; }
                    aR = MFMA32(ua, bb[j2], aR); aI = MFMA32(ua, bb[2 + j2], aI);
                    LAS unsigned char* bp = wl + (32 * j2 + c32) * SS_BU_PITCH + h * 32;
#pragma unroll
                    for (int g4 = 0; g4 < 4; ++g4)
#pragma unroll
                        for (int hh = 0; hh < 2; ++hh) { const int r0 = 4 * g4 + 2 * hh; const f32x4 v = {aR[r0], aI[r0], aR[r0 + 1], aI[r0 + 1]};
                            *(LAS f32x4*)(bp + (4 * g4 + hh) * 16) = v; } }
                {
                    const LAS unsigned char* rp = wl + lane * SS_BU_PITCH;
#pragma unroll
                    for (int q = 0; q < 16; ++q) { const f32x4 v = *(const LAS f32x4*)(rp + q * 16);
                        f32x2_t n0 = A2 * h2 + (B2 * __builtin_shufflevector(h2, h2, 1, 0) + (f32x2_t){v.x, v.y});
                        *(LAS unsigned*)(HS + (2 * q) * SS_HS_PITCH + lane * 4) = pk2(n0.x, n0.y);
                        f32x2_t n1 = A2 * n0 + (B2 * __builtin_shufflevector(n0, n0, 1, 0) + (f32x2_t){v.z, v.w});
                        *(LAS unsigned*)(HS + (2 * q + 1) * SS_HS_PITCH + lane * 4) = pk2(n1.x, n1.y);
                        h2 = n1; }
                }
                BAR_LDS();
            }
        }
        BAR_LDS();
        __builtin_amdgcn_s_setprio(0);
        if (!SAMPLE) { C.out()[O_REP + ((size_t)seq * 256 + g) * 64 + lane] = h2.x; C.out()[O_IMP + ((size_t)seq * 256 + g) * 64 + lane] = h2.y; }
    } else {
        bf16x8 cm[4];
#pragma unroll
        for (int s = 0; s < 4; ++s) cm[s] = *(const bf16x8*)(C.CMT() + ((size_t)g * 16 + c16) * 128 + 32 * s + 8 * q4);
        const float dsk = C.dssm()[g * 16 + c16];
        bf16* ygw = C.YG() + (mbase + (lane >> 1)) * E + g * 16 + (lane & 1) * 8;
        BAR_LDS();
#pragma unroll 1
        for (int cc = 0; cc < nchunk; ++cc) {
            {
                const LAS unsigned char* HS = wl + SS_HS + (cc & 1) * SS_HSB; const LAS unsigned char* UL = wl + SS_UL + (cc & 1) * 1024;
                LAS unsigned char* YL = wl + SS_HS + (cc & 1) * SS_HSB;
#pragma unroll
                for (int tt = 0; tt < 2; ++tt) { f32x4 y = {0.f, 0.f, 0.f, 0.f};
#pragma unroll
                    for (int s = 0; s < 4; ++s) { const bf16x8 a = *(const LAS bf16x8*)(HS + (16 * tt + c16) * SS_HS_PITCH + s * 64 + q4 * 16);
                        y = __builtin_amdgcn_mfma_f32_16x16x32_bf16(a, cm[s], y, 0, 0, 0); }
#pragma unroll
                    for (int r = 0; r < 4; ++r) { const int row = 16 * tt + 4 * q4 + r;
                        const float uv = bf2f(*(const LAS bf16*)(UL + row * 32 + c16 * 2));
                        *(LAS bf16*)(YL + row * 32 + c16 * 2) = f2bf(gelu_tanh(y[r] + dsk * uv)); } }
                *(v4u*)(ygw + (size_t)(cc * 32) * E) = *(const LAS v4u*)(YL + lane * 16); }
            BAR_LDS();
        }
    }
}
__device__ __forceinline__ void ssm_sample_unit(const Ctx& C, LAS unsigned char* wl, int g, int rb, int lane_in) {
    int lane = lane_in; asm volatile("" : "+v"(lane));
    const int c32 = lane & 31, h = lane >> 5, c16 = lane & 15, q4 = lane >> 4;
    const size_t m0 = (size_t)TP + rb * 32;
    const size_t sbase = ((size_t)(rb * 32) * 256 + g) * 64;
    const float* pr = C.sre() + sbase; const float* pi = C.sim() + sbase;
    float h0r[16], h0i[16];
#pragma unroll
    for (int r = 0; r < 16; ++r) { h0r[r] = __builtin_nontemporal_load((const float*)((const char*)pr + (unsigned)(r * 65536 + lane * 4))); h0i[r] = __builtin_nontemporal_load((const float*)((const char*)pi + (unsigned)(r * 65536 + lane * 4))); }
    const bf16x8 ua = *(const bf16x8*)(C.UZ() + (m0 + c32) * NZ + g * 16 + 8 * h);
    bf16x8 bb[4], cm[4];
#pragma unroll
    for (int j = 0; j < 4; ++j) bb[j] = *(const bf16x8*)(C.BBT() + ((size_t)g * 128 + 32 * j + c32) * 16 + 8 * h);
#pragma unroll
    for (int s = 0; s < 4; ++s) cm[s] = *(const bf16x8*)(C.CMT() + ((size_t)g * 16 + c16) * 128 + 32 * s + 8 * q4);
    const float ar = C.AR()[g * 64 + lane], ai = C.AI()[g * 64 + lane], dsk = C.dssm()[g * 16 + c16];
    LAS unsigned char* HS = wl + SS_HS; LAS unsigned char* UL = wl + SS_UL;
    *(LAS bf16x8*)(UL + c32 * 32 + h * 16) = ua;
#pragma unroll
    for (int j2 = 0; j2 < 2; ++j2) { f32x16 aR, aI;
#pragma unroll
        for (int r = 0; r < 16; ++r) { aR[r] = 0.f; aI[r] = 0.f; }
        aR = MFMA32(ua, bb[j2], aR); aI = MFMA32(ua, bb[2 + j2], aI);
        LAS unsigned char* bp = wl + (32 * j2 + c32) * SS_BU_PITCH + h * 32;
#pragma unroll
        for (int g4 = 0; g4 < 4; ++g4)
#pragma unroll
            for (int hh = 0; hh < 2; ++hh) { const int r0 = 4 * g4 + 2 * hh; const f32x4 v = {aR[r0], aI[r0], aR[r0 + 1], aI[r0 + 1]};
                *(LAS f32x4*)(bp + (4 * g4 + hh) * 16) = v; } }
    float* orp = C.out() + O_RES + sbase; float* oip = C.out() + O_IMS + sbase;
    const LAS unsigned char* rp = wl + lane * SS_BU_PITCH;
#pragma unroll
    for (int q = 0; q < 16; ++q) { const f32x4 v = *(const LAS f32x4*)(rp + q * 16);
        if (q == 8) {
#pragma unroll
            for (int r = 0; r < 16; ++r) { h0r[r] = *(const float*)((const char*)pr + (unsigned)((16 + r) * 65536 + lane * 4)); h0i[r] = *(const float*)((const char*)pi + (unsigned)((16 + r) * 65536 + lane * 4)); } }
#pragma unroll
        for (int e = 0; e < 2; ++e) { const int r = 2 * q + e; const float re = e ? v.z : v.x, im = e ? v.w : v.y;
            const float nr = ar * h0r[r & 15] - ai * h0i[r & 15] + re, ni = ar * h0i[r & 15] + ai * h0r[r & 15] + im;
            __builtin_nontemporal_store(nr, (float*)((char*)orp + (unsigned)(r * 65536 + lane * 4))); __builtin_nontemporal_store(ni, (float*)((char*)oip + (unsigned)(r * 65536 + lane * 4)));
            *(LAS unsigned*)(HS + r * SS_HS_PITCH + lane * 4) = pk2(nr, ni); } }
    bf16* yg = C.YG() + (m0 + 4 * q4) * E + g * 16 + c16;
#pragma unroll
    for (int tt = 0; tt < 2; ++tt) { f32x4 y = {0.f, 0.f, 0.f, 0.f};
#pragma unroll
        for (int s = 0; s < 4; ++s) { const bf16x8 a = *(const LAS bf16x8*)(HS + (16 * tt + c16) * SS_HS_PITCH + s * 64 + q4 * 16);
            y = __builtin_amdgcn_mfma_f32_16x16x32_bf16(a, cm[s], y, 0, 0, 0); }
#pragma unroll
        for (int r = 0; r < 4; ++r) { const int row = 16 * tt + 4 * q4 + r;
            const float uv = bf2f(*(const LAS bf16*)(UL + row * 32 + c16 * 2));
            yg[(size_t)(16 * tt + r) * E] = f2bf(gelu_tanh(y[r] + dsk * uv)); } }
}
__device__ __forceinline__ void phase7(const Ctx& C, LAS unsigned char* lds) {
    const int tid = fresh_tid();
    for (int ub = blockIdx.x * 4; ub < NB * 256; ub += gridDim.x * 4) ssm_round<false>(C, lds, ub, tid);
    const int lane = tid & 63, wave = __builtin_amdgcn_readfirstlane(tid >> 6);
    if (wave < 4) for (int u = blockIdx.x * 4 + wave; u < 1024; u += gridDim.x * 4) ssm_sample_unit(C, lds + wave * SS_SLOT, u & 255, u >> 8, lane);
}
__device__ __forceinline__ void grid_bar(unsigned* cnt, unsigned target) {
    __syncthreads();
    if (threadIdx.x == 0) {
        __builtin_amdgcn_fence(__ATOMIC_RELEASE, "agent");
        asm volatile("s_waitcnt vmcnt(0)" ::: "memory");
        __hip_atomic_fetch_add(cnt, 1u, __ATOMIC_RELAXED, __HIP_MEMORY_SCOPE_AGENT);
        unsigned spins = 0;
        while (__hip_atomic_load(cnt, __ATOMIC_RELAXED, __HIP_MEMORY_SCOPE_AGENT) < target && ++spins < (1u << 24)) __builtin_amdgcn_s_sleep(2);
        __builtin_amdgcn_fence(__ATOMIC_ACQUIRE, "agent");
    }
    __syncthreads();
}
__global__ void __launch_bounds__(512, 2) mk_fwd(Args a) {
    extern __shared__ __attribute__((aligned(16))) unsigned char lds_raw[];
    LAS unsigned char* lds = (LAS unsigned char*)lds_raw;
    cg::grid_group grid = cg::this_grid();
    const Ctx C{a};
    const int lo = a.ph_lo, hi = a.ph_hi; unsigned nbar = 0;
#ifdef ONLY
#define IN(k) ((k) == ONLY && lo <= (k) && (k) < hi)
#else
#define IN(k) (lo <= (k) && (k) < hi)
#endif
#define SEAM(k) do { if (IN(k) && IN((k) + 1)) { if ((k) == 0) grid.sync(); else { ++nbar; grid_bar(C.ctl() + 64, nbar * gridDim.x); } } } while (0)
    if (IN(0)) phase0(C, lds);
    SEAM(0);
    if (IN(1)) { pg8::Gemm g{C.H(), C.WT1(), TP, 12288, D}; pg8::StaticOrder S; S.init(TP, 12288, (int)gridDim.x, (int)blockIdx.x);
        EpiStore Ep{C.P1(), N1P}; if (!(a.flags & 2)) pg8::gemm_phase<EpiStore, pg8::StaticOrder, true, true>(lds, g, S, Ep);
        const int t1 = fresh_tid(), lane = t1 & 63, wave = __builtin_amdgcn_readfirstlane(t1 >> 6), i16 = lane & 15, q4 = lane >> 4;
        if (!(a.flags & 1)) {
            bf16* P1 = C.P1();
            for (int job = blockIdx.x; job < TP / 32; job += gridDim.x) { const int r0 = job * 32 + (wave >> 2) * 16, c0 = OFF_B + (wave & 3) * 16;
                skinny_wg<4, 1, D, D>(C.H() + (size_t)r0 * D, D, C.WT1() + (size_t)OFF_B * D, lds, t1, wave & 3, job >> 3, [&](int j, const f32x4 v) {
                    *(v2u*)(P1 + (size_t)(r0 + i16) * N1P + c0 + 4 * q4) = pk4(v); }); }
            for (int job = blockIdx.x; job < N1 / 64; job += gridDim.x) { const int r0 = TP + wave * 16, c0 = job * 64;
                skinny_wg<4, 4, D, D>(C.H() + (size_t)r0 * D, D, C.WT1() + (size_t)c0 * D, lds, t1, 0, job >> 3, [&](int j, const f32x4 v) {
                    *(v2u*)(P1 + (size_t)(r0 + i16) * N1P + c0 + 16 * j + 4 * q4) = pk4(v); }); }
        } }
    SEAM(1);
    if (IN(2)) phase2(C, lds);
    SEAM(2);
    if (IN(3)) phase3(C, lds);
    SEAM(3);
    if (IN(4)) { pg8::Gemm g{C.OG(), C.WT2(), TP, D, E}; pg8::StaticOrder S; S.init(TP, D, (int)gridDim.x, (int)blockIdx.x);
        EpiResid Ep{C.xp(), C.xs(), C.X1()}; if (!(a.flags & 2)) pg8::gemm_phase<EpiResid, pg8::StaticOrder, true, true>(lds, g, S, Ep);
        const int t1 = fresh_tid(), lane = t1 & 63, wave = __builtin_amdgcn_readfirstlane(t1 >> 6), i16 = lane & 15, q4 = lane >> 4;
        if (!(a.flags & 1)) {   float* X1 = C.X1(); const float* xs = C.xs();
            for (int job = blockIdx.x; job < 2 * (D / 16); job += gridDim.x) { const int r0 = TP + wave * 16, c0 = (job >> 1) * 16, kh = (job & 1) * (E / 2);
                skinny_wg<1, 1, E / 2, E>(C.OG() + (size_t)r0 * E + kh, E, C.WT2() + (size_t)c0 * E + kh, lds, t1, 0, job >> 3, [&](int j, const f32x4 v) {
                    float* p = X1 + (size_t)(r0 + i16) * D + c0 + 4 * q4;
                    atomicAdd(p, v[0]); atomicAdd(p + 1, v[1]); atomicAdd(p + 2, v[2]); atomicAdd(p + 3, v[3]); }); } } }
    SEAM(4);
    if (IN(5)) { const int t5 = fresh_tid(), lane = t5 & 63, gw = blockIdx.x * 8 + (t5 >> 6), NGW = gridDim.x * 8; for (int m = gw; m < MV; m += NGW) rms_row_bf16(C.X1() + (size_t)m * D, C.nssm(), C.H() + (size_t)m * D, lane); }
    SEAM(5);
    if (IN(6)) { pg8::Gemm g{C.H(), C.WT3(), TP, NZ, D}; pg8::StaticOrder S; S.init(TP, NZ, (int)gridDim.x, (int)blockIdx.x);
        EpiStore Ep{C.UZ(), NZ}; if (!(a.flags & 2)) pg8::gemm_phase<EpiStore, pg8::StaticOrder, true, true>(lds, g, S, Ep);
        const int t1 = fresh_tid(), lane = t1 & 63, wave = __builtin_amdgcn_readfirstlane(t1 >> 6), i16 = lane & 15, q4 = lane >> 4;
        if (!(a.flags & 1)) {   bf16* UZ = C.UZ();
            for (int job = blockIdx.x; job < NZ / 32; job += gridDim.x) { const int r0 = TP + wave * 16, c0 = job * 32;
                skinny_wg<2, 2, D, D>(C.H() + (size_t)r0 * D, D, C.WT3() + (size_t)c0 * D, lds, t1, 0, job >> 3, [&](int j, const f32x4 v) {
                    *(v2u*)(UZ + (size_t)(r0 + i16) * NZ + c0 + 16 * j + 4 * q4) = pk4(v); }); } } }
    SEAM(6);
    if (IN(7)) phase7(C, lds);
    SEAM(7);
    if (IN(8)) { pg8::Gemm g{C.YG(), C.WT4(), TP, E, E}; pg8::StaticOrder S; S.init(TP, E, (int)gridDim.x, (int)blockIdx.x);
        EpiGlu Ep{C.YG(), C.UZ(), C.bglu(), C.Y2()}; if (!(a.flags & 2)) pg8::gemm_phase<EpiGlu, pg8::StaticOrder, true, true>(lds, g, S, Ep);
        const int t1 = fresh_tid(), lane = t1 & 63, wave = __builtin_amdgcn_readfirstlane(t1 >> 6), i16 = lane & 15, q4 = lane >> 4;
        if (!(a.flags & 1)) {   bf16* Y2 = C.Y2(); const bf16* YG = C.YG(); const bf16* UZ = C.UZ(); const float* bg = C.bglu();
            for (int job = blockIdx.x; job < E / 16; job += gridDim.x) { const int r0 = TP + wave * 16, c0 = job * 16;
                skinny_wg<1, 1, E, E>(YG + (size_t)r0 * E, E, C.WT4() + (size_t)c0 * E, lds, t1, 0, job >> 3, [&](int j, const f32x4 v) {
                    const size_t r = r0 + i16; const int c = c0 + 4 * q4;
                    const v2u yv = *(const v2u*)(YG + r * E + c), zv = *(const v2u*)(UZ + r * NZ + E + c); const f32x4 gt = v + *(const f32x4*)(bg + c);
                    f32x4 o; o[0] = lo_bf(yv.x) * sigmoidf_(gt[0]) * siluf_(lo_bf(zv.x)); o[1] = hi_bf(yv.x) * sigmoidf_(gt[1]) * siluf_(hi_bf(zv.x));
                    o[2] = lo_bf(yv.y) * sigmoidf_(gt[2]) * siluf_(lo_bf(zv.y)); o[3] = hi_bf(yv.y) * sigmoidf_(gt[3]) * siluf_(hi_bf(zv.y));
                    *(v2u*)(Y2 + r * E + c) = pk4(o); }); } } }
    SEAM(8);
    if (IN(9)) { pg8::Gemm g{C.Y2(), C.WT5(), TP, D, E}; pg8::StaticOrder S; S.init(TP, D, (int)gridDim.x, (int)blockIdx.x);
        EpiResid2 Ep{C.X1()}; if (!(a.flags & 2)) pg8::gemm_phase<EpiResid2, pg8::StaticOrder, true, true>(lds, g, S, Ep);
        const int t1 = fresh_tid(), lane = t1 & 63, wave = __builtin_amdgcn_readfirstlane(t1 >> 6), i16 = lane & 15, q4 = lane >> 4;
        if (!(a.flags & 1)) {   float* X1 = C.X1();
            for (int job = blockIdx.x; job < 2 * (D / 16); job += gridDim.x) { const int r0 = TP + wave * 16, c0 = (job >> 1) * 16, kh = (job & 1) * (E / 2);
                skinny_wg<1, 1, E / 2, E>(C.Y2() + (size_t)r0 * E + kh, E, C.WT5() + (size_t)c0 * E + kh, lds, t1, 0, job >> 3, [&](int j, const f32x4 v) {
                    float* p = X1 + (size_t)(r0 + i16) * D + c0 + 4 * q4;
                    atomicAdd(p, v[0]); atomicAdd(p + 1, v[1]); atomicAdd(p + 2, v[2]); atomicAdd(p + 3, v[3]); }); } } }
    SEAM(9);
    if (IN(10)) { const int t10 = fresh_tid(), lane = t10 & 63, gw = blockIdx.x * 8 + (t10 >> 6), NGW = gridDim.x * 8; for (int m = gw; m < MV; m += NGW) rms_row_f32(C.X1() + (size_t)m * D, C.nfin(), m < TP ? C.out() + O_YP + (size_t)m * D : C.out() + O_YS + (size_t)(m - TP) * D, lane); }
}

#ifndef MK_SPLIT
#define MK_SPLIT 0
#endif
extern "C" void kernel_launch(void* const* d_in, const int* in_sizes, int n_in, void* d_out, int out_size, void* d_ws, size_t ws_size, hipStream_t stream) {
    static int grid = 0;
    if (grid == 0) {
        if (n_in != 27 || (size_t)out_size != O_END || ws_size < WS_END) { fprintf(stderr, "kernel_launch: unexpected problem (n_in %d, out %d, ws %zu)\n", n_in, out_size, ws_size); grid = -1; return; }
        int dev = 0, cus = 0, per_cu = 0;
        if (hipGetDevice(&dev) != hipSuccess || hipDeviceGetAttribute(&cus, hipDeviceAttributeMultiprocessorCount, dev) != hipSuccess) { grid = -1; return; }
        if (hipFuncSetAttribute((const void*)mk_fwd, hipFuncAttributeMaxDynamicSharedMemorySize, LDS_BYTES) != hipSuccess) { fprintf(stderr, "kernel_launch: hipFuncSetAttribute failed\n"); grid = -1; return; }
        if (hipOccupancyMaxActiveBlocksPerMultiprocessor(&per_cu, (const void*)mk_fwd, 512, LDS_BYTES) != hipSuccess || per_cu < 1) { fprintf(stderr, "kernel_launch: occupancy query says %d\n", per_cu); (void)hipGetLastError(); grid = -1; return; }
        grid = cus;
    }
    if (grid < 0) return;
    (void)hipMemsetAsync((char*)d_ws + WS_CTL, 0, 4096, stream);
    Args a{};
    for (int i = 0; i < 27; ++i) a.in[i] = (const float*)d_in[i];
    a.out = (float*)d_out; a.ws = (unsigned char*)d_ws;
#if MK_SPLIT
    for (int p = 0; p <= 10; ++p) { a.ph_lo = p; a.ph_hi = p + 1; hipLaunchKernelGGL(mk_fwd, dim3(grid), dim3(512), LDS_BYTES, stream, a); }
#else
    a.ph_lo = 0; a.ph_hi = 11;
    void* args[] = {&a};
    hipError_t e = hipLaunchCooperativeKernel((const void*)mk_fwd, dim3(grid), dim3(512), args, LDS_BYTES, stream);
    if (e != hipSuccess) fprintf(stderr, "kernel_launch: cooperative launch failed: %s (grid %d)\n", hipGetErrorString(e), grid);
#endif
#ifdef PROBE_EXTRA
    for (int p = 0; p <= 11; ++p) if ((PROBE_EXTRA >> p) & 1) {
        if (p == 3) (void)hipMemsetAsync((char*)d_ws + WS_CTL, 0, 4096, stream);
        a.ph_lo = p; a.ph_hi = p + 1; a.out = (float*)((char*)d_ws + 64 * MiB);
#ifdef PROBE_FLAGS
        a.flags = PROBE_FLAGS;
#endif
        hipLaunchKernelGGL(mk_fwd, dim3(grid), dim3(512), LDS_BYTES, stream, a); }
#endif
}
```

```cpp
#include <hip/hip_runtime.h>
#include <hip/hip_cooperative_groups.h>
#include <cstdio>
#include <cstdint>
namespace cg = cooperative_groups;
namespace pg8 {
#define PG8_LAS __attribute__((address_space(3)))
typedef unsigned short bf16_t;
typedef short bf16x8 __attribute__((ext_vector_type(8)));
typedef float f32x4 __attribute__((ext_vector_type(4)));
typedef unsigned u32x4 __attribute__((ext_vector_type(4)));
constexpr int BM = 256, BK = 64, HALF = 128, HTB = HALF * BK * 2  , STAGE_BYTES = 8 * HTB, NXCD = 8, WGM = 2;

__host__ __device__ __forceinline__ int lds_byte(int r, int c) { const int st = (r >> 4) * 2 + (c >> 5), rr = r & 15, cc = c & 31, ob = rr * 64 + cc * 2; return st * 1024 + (ob ^ (((ob >> 9) & 1) << 5)); }
__host__ __device__ __forceinline__ void stage_rc(int b, int& R, int& C) { const int st = b / 1024, sb = b % 1024, swz = sb ^ (((sb >> 9) & 1) << 5); R = (st >> 1) * 16 + swz / 64; C = (st & 1) * 32 + (swz % 64) / 2; }
__host__ __device__ __forceinline__ int perm32(int rho) { const int n = rho >> 4, i = rho & 15; return 8 * (i >> 2) + 4 * n + (i & 3); }

struct Unit { int pm, pn; };
struct Gemm { const bf16_t* A; const bf16_t* Bt; int M, N, K; };

struct StaticOrder {
    int nM, nN, nwg, G, c;
    __host__ __device__ void init(int M, int N, int G_, int c_) { nM = M / BM; nN = N / BM; nwg = nM * nN; G = G_; c = c_; }
    __host__ __device__ bool next(int i, Unit& u) const {
        const long L = (long)i * G + c; if (L >= nwg) return false;
        int wgid = (int)L; { const int q = nwg / NXCD, r = nwg % NXCD, xcd = wgid % NXCD, off = wgid / NXCD; wgid = (xcd < r ? xcd * (q + 1) : r * (q + 1) + (xcd - r) * q) + off; }
        const int nig = WGM * nN, gid = wgid / nig, fm = gid * WGM, gsz = (nM - fm) < WGM ? (nM - fm) : WGM;
        u.pm = fm + ((wgid % nig) % gsz); u.pn = (wgid % nig) / gsz; return true;
    }
    __device__ __forceinline__ void a_ready(const Unit&) const {}
    __device__ __forceinline__ void done(const Unit&) const {}
};

__device__ __forceinline__ unsigned cvt_pk_bf16(float lo, float hi) { unsigned r; asm volatile("v_cvt_pk_bf16_f32 %0, %1, %2" : "=v"(r) : "v"(lo), "v"(hi)); return r; }

template <class Epi, class Sched, bool ALIGN_EPI = false, bool SP2 = false>
__device__ __forceinline__ void gemm_phase(PG8_LAS unsigned char* lds, const Gemm g, const Sched& S, const Epi& E) {
    const int tid = threadIdx.x, wid = __builtin_amdgcn_readfirstlane(tid >> 6), lane = tid & 63, wr = wid >> 2, wc = wid & 3, fr = lane & 15, fq = lane >> 4;
    const int K = g.K, nt = K / BK;
    unsigned voffA[2], voffB[2];
#pragma unroll
    for (int i = 0; i < 2; ++i) { int R, C; stage_rc(tid * 16 + i * 8192, R, C); const int Rb = Epi::PERM ? ((R & ~31) + perm32(R & 31)) : R;
        voffA[i] = (unsigned)(R * K + C) * 2u; voffB[i] = (unsigned)(Rb * K + C) * 2u; }
    const size_t kstep = (size_t)(BK * 2);
    const size_t hstep = (size_t)HALF * K * 2;
    const size_t tstep = 2 * hstep;
    const unsigned ldsw = (unsigned)wid * 1024u;
    const int aoff = lds_byte(wr * 64 + fr, fq * 8), boff = lds_byte(wc * 32 + fr, fq * 8);
#define PG8_SA(b, h) (((b) * 2 + (h)) * HTB)
#define PG8_SB(b, h) ((4 + (b) * 2 + (h)) * HTB)
#define PG8_STAGE(bufoff, gbase, voff) do { _Pragma("unroll") for (int _i = 0; _i < 2; ++_i) \
        __builtin_amdgcn_global_load_lds((const unsigned*)((const char*)(gbase) + (voff)[_i]), (PG8_LAS unsigned*)(lds + (bufoff) + ldsw + _i * 8192), 16, 0, 0); } while (0)
#define PG8_LDA(dst, b, h) do { _Pragma("unroll") for (int m = 0; m < 4; ++m) _Pragma("unroll") for (int k = 0; k < 2; ++k) dst[m][k] = *(const PG8_LAS bf16x8*)(lds + PG8_SA(b, h) + aoff + m * 2048 + k * 1024); } while (0)
#define PG8_LDB(dst, b, h) do { _Pragma("unroll") for (int n = 0; n < 2; ++n) _Pragma("unroll") for (int k = 0; k < 2; ++k) dst[n][k] = *(const PG8_LAS bf16x8*)(lds + PG8_SB(b, h) + boff + n * 2048 + k * 1024); } while (0)
#define PG8_MMA(ai, bj, At, Bt) do { __builtin_amdgcn_s_setprio(1); _Pragma("unroll") for (int m = 0; m < 4; ++m) _Pragma("unroll") for (int n = 0; n < 2; ++n) _Pragma("unroll") for (int k = 0; k < 2; ++k) \
        acc[ai][bj][m][n] = __builtin_amdgcn_mfma_f32_16x16x32_bf16(Bt[n][k], At[m][k], acc[ai][bj][m][n], 0, 0, 0); __builtin_amdgcn_s_setprio(0); } while (0)
#define PG8_WAIT_V(n) asm volatile("s_waitcnt vmcnt(" #n ")" ::: "memory")
#define PG8_WAIT_L(n) asm volatile("s_waitcnt lgkmcnt(" #n ")" ::: "memory")
#define PG8_BAR __builtin_amdgcn_s_barrier()
#define PG8_SCHED __builtin_amdgcn_sched_barrier(0)
    Unit cur, nxt; int ui = 0;
    if (!S.next(0, cur)) return;
    f32x4 acc[2][2][4][2];
#pragma unroll
    for (int a = 0; a < 2; ++a)
#pragma unroll
        for (int b = 0; b < 2; ++b)
#pragma unroll
            for (int m = 0; m < 4; ++m)
#pragma unroll
                for (int n = 0; n < 2; ++n) acc[a][b][m][n] = (f32x4){0.f, 0.f, 0.f, 0.f};
    bf16x8 At[4][2], B0[2][2], B1[2][2];
    const char* cA = (const char*)g.A + (size_t)cur.pm * tstep; const char* cB = (const char*)g.Bt + (size_t)cur.pn * tstep;
    S.a_ready(cur);
    if constexpr (SP2) {
        PG8_STAGE(PG8_SB(0, 0), cB, voffB); PG8_STAGE(PG8_SB(0, 1), cB + hstep, voffB); PG8_STAGE(PG8_SA(0, 0), cA, voffA); PG8_STAGE(PG8_SA(0, 1), cA + hstep, voffA);
        if (wr == 1) PG8_BAR;
        PG8_WAIT_V(2); PG8_BAR;
        PG8_STAGE(PG8_SB(1, 0), cB + kstep, voffB); PG8_STAGE(PG8_SA(1, 0), cA + kstep, voffA); PG8_STAGE(PG8_SB(1, 1), cB + hstep + kstep, voffB);
        PG8_WAIT_V(6); PG8_BAR;
    } else {
        PG8_STAGE(PG8_SB(0, 0), cB, voffB); PG8_STAGE(PG8_SA(0, 0), cA, voffA); PG8_STAGE(PG8_SB(0, 1), cB + hstep, voffB); PG8_STAGE(PG8_SA(0, 1), cA + hstep, voffA);
        if (wr == 1) PG8_BAR;
        PG8_WAIT_V(4); PG8_BAR;
        PG8_STAGE(PG8_SB(1, 0), cB + kstep, voffB); PG8_STAGE(PG8_SA(1, 0), cA + kstep, voffA); PG8_STAGE(PG8_SB(1, 1), cB + hstep + kstep, voffB);
        PG8_WAIT_V(6); PG8_BAR;
    }
    for (;;) {
        const bool has_next = S.next(ui + 1, nxt);
        const char* nA = has_next ? (const char*)g.A + (size_t)nxt.pm * tstep : cA; const char* nB = has_next ? (const char*)g.Bt + (size_t)nxt.pn * tstep : cB;
        for (int t = 0; t < nt; t += 2) {
            const bool last = (t == nt - 2);
            const char* a1 = cA + (size_t)(t + 1) * kstep;
            const char* a2 = last ? nA : cA + (size_t)(t + 2) * kstep; const char* b2 = last ? nB : cB + (size_t)(t + 2) * kstep;
            const char* a3 = a2 + kstep; const char* b3 = b2 + kstep;
            if (last && has_next) S.a_ready(nxt);
            if constexpr (SP2) {
            PG8_LDB(B0, 0, 0); PG8_LDB(B1, 0, 1); PG8_SCHED; PG8_LDA(At, 0, 0); PG8_STAGE(PG8_SA(1, 1), a1 + hstep, voffA);
            PG8_WAIT_V(8); PG8_WAIT_L(0); PG8_BAR; PG8_MMA(0, 0, At, B0); PG8_MMA(0, 1, At, B1); PG8_BAR; PG8_SCHED;
            PG8_LDA(At, 0, 1); PG8_STAGE(PG8_SB(0, 0), b2, voffB); PG8_STAGE(PG8_SB(0, 1), b2 + hstep, voffB); PG8_STAGE(PG8_SA(0, 0), a2, voffA);
            PG8_WAIT_V(8); PG8_WAIT_L(0); PG8_BAR; PG8_MMA(1, 0, At, B0); PG8_MMA(1, 1, At, B1); PG8_BAR; PG8_SCHED;
            PG8_LDB(B0, 1, 0); PG8_LDB(B1, 1, 1); PG8_SCHED; PG8_LDA(At, 1, 0); PG8_STAGE(PG8_SA(0, 1), a2 + hstep, voffA);
            PG8_WAIT_V(8); PG8_WAIT_L(0); PG8_BAR; PG8_MMA(0, 0, At, B0); PG8_MMA(0, 1, At, B1); PG8_BAR; PG8_SCHED;
            PG8_LDA(At, 1, 1); PG8_STAGE(PG8_SB(1, 0), b3, voffB); PG8_STAGE(PG8_SB(1, 1), b3 + hstep, voffB); PG8_STAGE(PG8_SA(1, 0), a3, voffA);
            PG8_WAIT_V(8); PG8_WAIT_L(0); PG8_BAR; PG8_MMA(1, 0, At, B0); PG8_MMA(1, 1, At, B1); PG8_BAR; PG8_SCHED;
            } else {
            PG8_LDB(B0, 0, 0); PG8_SCHED; PG8_LDA(At, 0, 0); PG8_STAGE(PG8_SA(1, 1), a1 + hstep, voffA);
            PG8_WAIT_L(8); PG8_BAR; PG8_WAIT_L(0); PG8_MMA(0, 0, At, B0); PG8_BAR; PG8_SCHED;
            PG8_LDB(B1, 0, 1); PG8_STAGE(PG8_SB(0, 0), b2, voffB);
            PG8_BAR; PG8_WAIT_L(0); PG8_MMA(0, 1, At, B1); PG8_BAR;
            PG8_LDA(At, 0, 1); PG8_STAGE(PG8_SA(0, 0), a2, voffA);
            PG8_BAR; PG8_WAIT_L(0); PG8_MMA(1, 0, At, B0); PG8_BAR; PG8_SCHED;
            PG8_STAGE(PG8_SB(0, 1), b2 + hstep, voffB);
            PG8_WAIT_V(6); PG8_BAR; PG8_MMA(1, 1, At, B1); PG8_BAR;
            PG8_LDB(B0, 1, 0); PG8_SCHED; PG8_LDA(At, 1, 0); PG8_STAGE(PG8_SA(0, 1), a2 + hstep, voffA);
            PG8_WAIT_L(8); PG8_BAR; PG8_WAIT_L(0); PG8_MMA(0, 0, At, B0); PG8_BAR; PG8_SCHED;
            PG8_LDB(B1, 1, 1); PG8_STAGE(PG8_SB(1, 0), b3, voffB);
            PG8_BAR; PG8_WAIT_L(0); PG8_MMA(0, 1, At, B1); PG8_BAR;
            PG8_LDA(At, 1, 1); PG8_STAGE(PG8_SA(1, 0), a3, voffA);
            PG8_BAR; PG8_WAIT_L(0); PG8_MMA(1, 0, At, B0); PG8_BAR; PG8_SCHED;
            PG8_STAGE(PG8_SB(1, 1), b3 + hstep, voffB);
            PG8_WAIT_V(6); PG8_BAR; PG8_MMA(1, 1, At, B1); PG8_BAR;
            }
        }
        if constexpr (ALIGN_EPI) { if (wr == 0) PG8_BAR; }
        if constexpr (!Epi::AFTER_DRAIN) { E(acc, cur, wr, wc, fr, fq); S.done(cur); }
        if (!has_next) break;
#pragma unroll
        for (int a = 0; a < 2; ++a)
#pragma unroll
            for (int b = 0; b < 2; ++b)
#pragma unroll
                for (int m = 0; m < 4; ++m)
#pragma unroll
                    for (int n = 0; n < 2; ++n) acc[a][b][m][n] = (f32x4){0.f, 0.f, 0.f, 0.f};
        cur = nxt; cA = nA; cB = nB; ++ui;
        if constexpr (ALIGN_EPI) { if (wr == 1) PG8_BAR; }
    }
    PG8_WAIT_V(0);
    if constexpr (!ALIGN_EPI) { if (wr == 0) PG8_BAR; }
    PG8_BAR;
    if constexpr (Epi::AFTER_DRAIN) { E.fused(acc, cur, wr, wc, fr, fq, lds, wid, lane); S.done(cur); }
#undef PG8_SA
#undef PG8_SB
#undef PG8_STAGE
#undef PG8_LDA
#undef PG8_LDB
#undef PG8_MMA
#undef PG8_WAIT_V
#undef PG8_WAIT_L
#undef PG8_BAR
#undef PG8_SCHED
}
}

#define LAS __attribute__((address_space(3)))
typedef unsigned short bf16;
typedef unsigned v4u __attribute__((ext_vector_type(4)));
typedef unsigned v2u __attribute__((ext_vector_type(2)));
typedef float f32x4 __attribute__((ext_vector_type(4)));
typedef float f32x16 __attribute__((ext_vector_type(16)));
typedef short bf16x8 __attribute__((ext_vector_type(8)));
typedef __bf16 bf16x2_t __attribute__((ext_vector_type(2)));
typedef float f32x2_t __attribute__((ext_vector_type(2)));

constexpr int D = 2048, TP = 8192, NSMP = 128, MV = TP + NSMP, MP = 8448;
constexpr int SEQ = 2048, NB = 4;
constexpr int N1 = 12352, N1P = 12544;
constexpr int E = 4096;
constexpr int NZ = 8192;
constexpr int OFF_B = 12288, OFF_A = 12320;
constexpr int LDS_BYTES = 147456;
constexpr float RMS_EPS = 1e-6f;

constexpr size_t MiB = 1u << 20;
constexpr size_t WS_CTL = 0;
constexpr size_t WS_WT1 = 1 * MiB, WS_WT2 = 50 * MiB, WS_WT3 = 66 * MiB, WS_WT4 = 98 * MiB, WS_WT5 = 130 * MiB;
constexpr size_t WS_AR = 146 * MiB, WS_AI = WS_AR + 65536, WS_GL = WS_AI + 65536, WS_BBT = 147 * MiB, WS_CMT = 148 * MiB;
constexpr size_t WS_H = 149 * MiB;
constexpr size_t WS_P1 = 182 * MiB;
constexpr size_t WS_UZ = WS_P1;
constexpr size_t WS_REC = 385 * MiB;
constexpr size_t WS_YG = WS_REC, WS_Y2 = WS_REC + 66 * MiB;
constexpr size_t WS_OG = 673 * MiB;
constexpr size_t WS_X1 = 739 * MiB;
constexpr size_t WS_END = 805 * MiB;
constexpr int REC_BYTES = 73728, REC_WN = 0, REC_QD = 16384, REC_AT = 32768, REC_KDT = 40960, REC_UT = 57344;

constexpr size_t O_YP = 0, O_YS = 16777216, O_CONVP = O_YS + 262144, O_DELTAP = O_CONVP + 98304, O_REP = O_DELTAP + 2097152, O_IMP = O_REP + 65536,
                 O_CONVS = O_IMP + 65536, O_DELTAS = O_CONVS + 3145728, O_RES = O_DELTAS + 67108864, O_IMS = O_RES + 2097152, O_END = O_IMS + 2097152;

__device__ __forceinline__ float bf2f(unsigned short u) { return __uint_as_float((unsigned)u << 16); }
__device__ __forceinline__ unsigned pk2(float lo, float hi) { f32x2_t v = {lo, hi}; bf16x2_t b = __builtin_convertvector(v, bf16x2_t); return __builtin_bit_cast(unsigned, b); }
__device__ __forceinline__ unsigned short f2bf(float f) { return (unsigned short)(pk2(f, 0.f) & 0xffffu); }
__device__ __forceinline__ float lo_bf(unsigned u) { return __uint_as_float(u << 16); }
__device__ __forceinline__ float hi_bf(unsigned u) { return __uint_as_float(u & 0xffff0000u); }
__device__ __forceinline__ float wave_sum(float v) {
#pragma unroll
    for (int o = 1; o < 64; o <<= 1) v += __shfl_xor(v, o);
    return v;
}
__device__ __forceinline__ float sigmoidf_(float x) { return __builtin_amdgcn_rcpf(1.f + __expf(-x)); }
__device__ __forceinline__ float siluf_(float x) { return x * __builtin_amdgcn_rcpf(1.f + __expf(-x)); }
__device__ __forceinline__ float gelu_tanh(float x) {
    const float u = 0.7978845608028654f * (x + 0.044715f * x * x * x);
    const float t = 1.f - 2.f * __builtin_amdgcn_rcpf(1.f + __expf(2.f * u));
    return 0.5f * x * (1.f + t);
}
#define LDS_WAIT() asm volatile("s_waitcnt lgkmcnt(0)" ::: "memory")
#define MFMA32(a, b, c) __builtin_amdgcn_mfma_f32_32x32x16_bf16((a), (b), (c), 0, 0, 0)
#define BAR_LDS() do { asm volatile("s_waitcnt lgkmcnt(0)" ::: "memory"); __builtin_amdgcn_s_barrier(); asm volatile("" ::: "memory"); } while (0)
__device__ __forceinline__ int fresh_tid() { int t = threadIdx.x; asm volatile("" : "+v"(t)); return t; }

struct Args { const float* in[27]; float* out; unsigned char* ws; int ph_lo, ph_hi, flags, pad; };
struct Ctx {
    const Args& a;
#define CIN(name, k) __device__ __forceinline__ const float* name() const { return a.in[k]; }
    CIN(xp, 0) CIN(xs, 1) CIN(cs, 2) CIN(ds, 3) CIN(sre, 4) CIN(sim, 5) CIN(ng, 6) CIN(wing, 7) CIN(convw, 8) CIN(alog, 9) CIN(dtb, 10) CIN(onorm, 11) CIN(woutg, 12) CIN(nssm, 13)
    CIN(wins, 14) CIN(lre, 15) CIN(lim, 16) CIN(bre, 17) CIN(bim, 18) CIN(cre, 19) CIN(cim, 20) CIN(dssm, 21) CIN(logdt, 22) CIN(wglu, 23) CIN(bglu, 24) CIN(wouts, 25) CIN(nfin, 26)
#undef CIN
    __device__ __forceinline__ float* out() const { return a.out; }
#define CWS(type, name, off) __device__ __forceinline__ type* name() const { return (type*)(a.ws + (off)); }
    CWS(bf16, WT1, WS_WT1) CWS(bf16, WT2, WS_WT2) CWS(bf16, WT3, WS_WT3) CWS(bf16, WT4, WS_WT4) CWS(bf16, WT5, WS_WT5) CWS(bf16, H, WS_H) CWS(bf16, P1, WS_P1) CWS(bf16, OG, WS_OG)
    CWS(bf16, UZ, WS_UZ) CWS(bf16, YG, WS_YG) CWS(bf16, Y2, WS_Y2) CWS(bf16, BBT, WS_BBT) CWS(bf16, CMT, WS_CMT) CWS(float, X1, WS_X1) CWS(float, AR, WS_AR) CWS(float, AI, WS_AI)
    CWS(float, GL, WS_GL) CWS(unsigned char, REC, WS_REC) CWS(unsigned, ctl, WS_CTL)
#undef CWS
};

struct EpiStore {
    static constexpr bool PERM = true, AFTER_DRAIN = false;
    bf16* O; int ldc;
    __device__ __forceinline__ void operator()(const pg8::f32x4 (&acc)[2][2][4][2], const pg8::Unit& u, int wr, int wc, int fr, int fq) const {
        const int row0 = u.pm * 256 + wr * 64 + fr, col0 = u.pn * 256 + wc * 32 + 8 * fq;
#pragma unroll
        for (int ai = 0; ai < 2; ++ai)
#pragma unroll
            for (int m = 0; m < 4; ++m) { bf16* rowp = O + (size_t)(row0 + ai * 128 + m * 16) * ldc + col0;
#pragma unroll
                for (int bj = 0; bj < 2; ++bj) { const pg8::f32x4 v0 = acc[ai][bj][m][0], v1 = acc[ai][bj][m][1];
                    v4u w; w.x = pk2(v0[0], v0[1]); w.y = pk2(v0[2], v0[3]); w.z = pk2(v1[0], v1[1]); w.w = pk2(v1[2], v1[3]);
                    *(v4u*)(rowp + bj * 128) = w; } }
    }
};
struct EpiResid {
    static constexpr bool PERM = true, AFTER_DRAIN = false;
    const float* xp; const float* xs; float* X1;
    __device__ __forceinline__ void operator()(const pg8::f32x4 (&acc)[2][2][4][2], const pg8::Unit& u, int wr, int wc, int fr, int fq) const {
        const int row0 = u.pm * 256 + wr * 64 + fr, col0 = u.pn * 256 + wc * 32 + 8 * fq;
#pragma unroll
        for (int ai = 0; ai < 2; ++ai)
#pragma unroll
            for (int m = 0; m < 4; ++m) { const int r = row0 + ai * 128 + m * 16;
                if (r < MV) { const float* xr = (r < TP ? xp + (size_t)r * D : xs + (size_t)(r - TP) * D) + col0; float* orow = X1 + (size_t)r * D + col0;
#pragma unroll
                    for (int bj = 0; bj < 2; ++bj) { const f32x4 a0 = __builtin_nontemporal_load((const f32x4*)(xr + bj * 128)), a1 = __builtin_nontemporal_load((const f32x4*)(xr + bj * 128 + 4));
                        *(f32x4*)(orow + bj * 128) = a0 + acc[ai][bj][m][0]; *(f32x4*)(orow + bj * 128 + 4) = a1 + acc[ai][bj][m][1]; } } }
    }
};
struct EpiResid2 {
    static constexpr bool PERM = true, AFTER_DRAIN = false;
    float* X1;
    __device__ __forceinline__ void operator()(const pg8::f32x4 (&acc)[2][2][4][2], const pg8::Unit& u, int wr, int wc, int fr, int fq) const {
        const int row0 = u.pm * 256 + wr * 64 + fr, col0 = u.pn * 256 + wc * 32 + 8 * fq;
#pragma unroll
        for (int ai = 0; ai < 2; ++ai)
#pragma unroll
            for (int m = 0; m < 4; ++m) { const int r = row0 + ai * 128 + m * 16;
                if (r < MV) { float* orow = X1 + (size_t)r * D + col0;
#pragma unroll
                    for (int bj = 0; bj < 2; ++bj) { const f32x4 a0 = *(const f32x4*)(orow + bj * 128), a1 = *(const f32x4*)(orow + bj * 128 + 4);
                        *(f32x4*)(orow + bj * 128) = a0 + acc[ai][bj][m][0]; *(f32x4*)(orow + bj * 128 + 4) = a1 + acc[ai][bj][m][1]; } } }
    }
};
struct EpiGlu {
    static constexpr bool PERM = true, AFTER_DRAIN = false;
    const bf16* YG; const bf16* UZ; const float* bglu; bf16* Y2;
    __device__ __forceinline__ void operator()(const pg8::f32x4 (&acc)[2][2][4][2], const pg8::Unit& u, int wr, int wc, int fr, int fq) const {
        const int row0 = u.pm * 256 + wr * 64 + fr, col0 = u.pn * 256 + wc * 32 + 8 * fq;
#pragma unroll
        for (int bj = 0; bj < 2; ++bj) { const int c = col0 + bj * 128; const f32x4 b0 = *(const f32x4*)(bglu + c), b1 = *(const f32x4*)(bglu + c + 4);
#pragma unroll
            for (int ai = 0; ai < 2; ++ai)
#pragma unroll
                for (int m = 0; m < 4; ++m) { const size_t r = (size_t)(row0 + ai * 128 + m * 16);
                    const v4u yv = *(const v4u*)(YG + r * E + c), zv = __builtin_nontemporal_load((const v4u*)(UZ + r * NZ + E + c));
                    const f32x4 g0 = acc[ai][bj][m][0] + b0, g1 = acc[ai][bj][m][1] + b1;
                    float o[8];
                    o[0] = lo_bf(yv.x) * sigmoidf_(g0[0]) * siluf_(lo_bf(zv.x)); o[1] = hi_bf(yv.x) * sigmoidf_(g0[1]) * siluf_(hi_bf(zv.x));
                    o[2] = lo_bf(yv.y) * sigmoidf_(g0[2]) * siluf_(lo_bf(zv.y)); o[3] = hi_bf(yv.y) * sigmoidf_(g0[3]) * siluf_(hi_bf(zv.y));
                    o[4] = lo_bf(yv.z) * sigmoidf_(g1[0]) * siluf_(lo_bf(zv.z)); o[5] = hi_bf(yv.z) * sigmoidf_(g1[1]) * siluf_(hi_bf(zv.z));
                    o[6] = lo_bf(yv.w) * sigmoidf_(g1[2]) * siluf_(lo_bf(zv.w)); o[7] = hi_bf(yv.w) * sigmoidf_(g1[3]) * siluf_(hi_bf(zv.w));
                    v4u w; w.x = pk2(o[0], o[1]); w.y = pk2(o[2], o[3]); w.z = pk2(o[4], o[5]); w.w = pk2(o[6], o[7]);
                    *(v4u*)(Y2 + r * E + c) = w; } }
    }
};

template <bool NTS = false>
__device__ __forceinline__ void p0_transpose_item(const float* W, int K, int N, bf16* WT, LAS float* scr, int item, int lane) {
    const int nblk = N / 32, kb = item / nblk, nb = item % nblk, k0 = 64 * kb, n0 = 32 * nb;
#pragma unroll 8
    for (int i = 0; i < 32; ++i) { const int kk = 2 * i + (lane >> 5); scr[kk * 33 + (lane & 31)] = __builtin_nontemporal_load(W + (size_t)(k0 + kk) * N + n0 + (lane & 31)); }
    LDS_WAIT(); asm volatile("" ::: "memory");
    const int c = lane & 7;
#pragma unroll
    for (int j = 0; j < 4; ++j) { const int n = (lane >> 3) + 8 * j; const LAS float* s = scr + (8 * c) * 33 + n;
        v4u o; o.x = pk2(s[0 * 33], s[1 * 33]); o.y = pk2(s[2 * 33], s[3 * 33]); o.z = pk2(s[4 * 33], s[5 * 33]); o.w = pk2(s[6 * 33], s[7 * 33]);
        if (NTS) __builtin_nontemporal_store(o, (v4u*)(WT + (size_t)(n0 + n) * K + k0 + 8 * c)); else *(v4u*)(WT + (size_t)(n0 + n) * K + k0 + 8 * c) = o; }
    LDS_WAIT(); asm volatile("" ::: "memory");
}
template <bool NT = false>
__device__ __forceinline__ void rms_row_bf16(const float* xrow, const float* g, bf16* orow, int lane) {
    const f32x4* xr = (const f32x4*)xrow + lane; f32x4 v[8]; float s = 0.f;
#pragma unroll
    for (int j = 0; j < 8; ++j) { v[j] = NT ? __builtin_nontemporal_load(xr + 64 * j) : xr[64 * j]; s += (v[j].x * v[j].x + v[j].y * v[j].y) + (v[j].z * v[j].z + v[j].w * v[j].w); }
    const float rs = 1.f / sqrtf(wave_sum(s) * (1.f / D) + RMS_EPS);
    const f32x4* gr = (const f32x4*)g + lane; v2u* o8 = (v2u*)orow + lane;
#pragma unroll
    for (int j = 0; j < 8; ++j) { const f32x4 gv = gr[64 * j]; v2u o; o.x = pk2(v[j].x * rs * gv.x, v[j].y * rs * gv.y); o.y = pk2(v[j].z * rs * gv.z, v[j].w * rs * gv.w); o8[64 * j] = o; }
}
__device__ __forceinline__ void rms_row_f32(const float* xrow, const float* g, float* orow, int lane) {
    const f32x4* xr = (const f32x4*)xrow + lane; f32x4 v[8]; float s = 0.f;
#pragma unroll
    for (int j = 0; j < 8; ++j) { v[j] = __builtin_nontemporal_load(xr + 64 * j); s += (v[j].x * v[j].x + v[j].y * v[j].y) + (v[j].z * v[j].z + v[j].w * v[j].w); }
    const float rs = 1.f / sqrtf(wave_sum(s) * (1.f / D) + RMS_EPS);
    const f32x4* gr = (const f32x4*)g + lane; f32x4* o = (f32x4*)orow + lane;
#pragma unroll
    for (int j = 0; j < 8; ++j) { const f32x4 gv = gr[64 * j]; __builtin_nontemporal_store(v[j] * rs * gv, o + 64 * j); }
}
__device__ __forceinline__ void phase0(const Ctx& C, LAS unsigned char* lds) {
    const int tid = fresh_tid(), lane = tid & 63, wave = tid >> 6;
    const int gw = blockIdx.x * 8 + wave, NGW = gridDim.x * 8;
    LAS float* scr = (LAS float*)(lds + wave * 16384);
    constexpr int I1 = (D / 64) * (N1 / 32), I2 = (E / 64) * (D / 32), I3 = (D / 64) * (NZ / 32), I4 = (E / 64) * (E / 32), I5 = I2, NIT = I1 + I2 + I3 + I4 + I5;
    for (int it = gw; it < NIT; it += NGW) {
        int r = it;
        if (r < I1) { p0_transpose_item(C.wing(), D, N1, C.WT1(), scr, r, lane); continue; } r -= I1;
        if (r < I2) { p0_transpose_item<true>(C.woutg(), E, D, C.WT2(), scr, r, lane); continue; } r -= I2;
        if (r < I3) { p0_transpose_item<true>(C.wins(), D, NZ, C.WT3(), scr, r, lane); continue; } r -= I3;
        if (r < I4) { p0_transpose_item<true>(C.wglu(), E, E, C.WT4(), scr, r, lane); continue; } r -= I4;
        p0_transpose_item<true>(C.wouts(), E, D, C.WT5(), scr, r, lane);
    }
    const int gt = blockIdx.x * 512 + tid, NGT = gridDim.x * 512;
    {
        v4u* z = (v4u*)(C.WT1() + (size_t)N1 * D); const v4u zero = {0u, 0u, 0u, 0u};
        for (int i = gt; i < (N1P - N1) * D / 8; i += NGT) z[i] = zero;
    }
    for (int m = gw; m < MP; m += NGW) {
        if (m < MV) rms_row_bf16<true>(m < TP ? C.xp() + (size_t)m * D : C.xs() + (size_t)(m - TP) * D, C.ng(), C.H() + (size_t)m * D, lane);
        else { v4u* o = (v4u*)(C.H() + (size_t)m * D); const v4u zero = {0u, 0u, 0u, 0u};
#pragma unroll
            for (int j = 0; j < 4; ++j) o[lane + 64 * j] = zero; }
    }
    if (gt < 256 * 64) {
        const int g = gt >> 6, p = gt & 63;
        const float lr = fminf(C.lre()[gt], -1e-4f), li = C.lim()[gt], dt = expf(C.logdt()[g]);
        const float mag = expf(lr * dt), ar = mag * cosf(li * dt), ai = mag * sinf(li * dt);
        const float den = lr * lr + li * li, xr = ar - 1.f, fr = (xr * lr + ai * li) / den, fi = (ai * lr - xr * li) / den;
        C.AR()[gt] = ar; C.AI()[gt] = ai;
        const float* br = C.bre() + (size_t)gt * 16; const float* bi = C.bim() + (size_t)gt * 16;
        bf16* o_re = C.BBT() + ((size_t)g * 128 + p) * 16; bf16* o_im = C.BBT() + ((size_t)g * 128 + 64 + p) * 16;
#pragma unroll
        for (int c = 0; c < 16; ++c) { const float b_r = br[c], b_i = bi[c]; o_re[c] = f2bf(fr * b_r - fi * b_i); o_im[c] = f2bf(fr * b_i + fi * b_r); }
#pragma unroll
        for (int c = 0; c < 16; ++c) { const size_t ci = ((size_t)g * 16 + c) * 64 + p; bf16* cm = C.CMT() + ((size_t)g * 16 + c) * 128;
            *(unsigned*)(cm + 2 * p) = pk2(C.cre()[ci], -C.cim()[ci]); }
    }
    {
        const f32x4* src = (const f32x4*)C.xs(); f32x4* dst = (f32x4*)(C.X1() + (size_t)TP * D);
        for (int i = gt; i < NSMP * D / 4; i += NGT) dst[i] = src[i];
    }
    {
        const f32x4* src = (const f32x4*)C.cs(); f32x4* dst = (f32x4*)(C.out() + O_CONVS);
        for (int i = gt; i < NSMP * 2 * 2048; i += NGT) { const int b = i / 4096, rem = i % 4096, r = rem / 2048, c4 = rem % 2048;
            dst[((size_t)b * 3 + r) * 2048 + c4] = src[((size_t)b * 3 + r + 1) * 2048 + c4]; }
    }
}

template <int CB, int K, class F>
__device__ __forceinline__ void skinny_wave(const bf16* A, int lda, const bf16* Bt, int lane, int rot, F&& epi) {
    const int i16 = lane & 15, q4 = lane >> 4;
    const bf16* ap = A + (size_t)i16 * lda + 8 * q4;
    const bf16* bp = Bt + (size_t)i16 * K + 8 * q4;
    f32x4 acc[CB];
#pragma unroll
    for (int j = 0; j < CB; ++j) acc[j] = (f32x4){0.f, 0.f, 0.f, 0.f};
    constexpr int U = CB == 1 ? 8 : 4;
    constexpr int nst = K / (32 * U); const int kofs = (rot * 32 * U) & (K - 1);
    bf16x8 a[2][U], b[2][CB][U];
#define SK_ISSUE(buf, st) do { const int k_ = (((st) < nst ? (st) : nst - 1) * 32 * U + kofs) & (K - 1); _Pragma("unroll") for (int u = 0; u < U; ++u) { a[buf][u] = *(const bf16x8*)(ap + k_ + 32 * u); \
        _Pragma("unroll") for (int j = 0; j < CB; ++j) b[buf][j][u] = *(const bf16x8*)(bp + (size_t)(16 * j) * K + k_ + 32 * u); } } while (0)
#define SK_MMA(buf) do { _Pragma("unroll") for (int u = 0; u < U; ++u) _Pragma("unroll") for (int j = 0; j < CB; ++j) acc[j] = __builtin_amdgcn_mfma_f32_16x16x32_bf16(b[buf][j][u], a[buf][u], acc[j], 0, 0, 0); } while (0)
    SK_ISSUE(0, 0);
#pragma unroll
    for (int st = 0; st < nst; st += 2) {
        SK_ISSUE(1, st + 1); __builtin_amdgcn_sched_barrier(0); SK_MMA(0); __builtin_amdgcn_sched_barrier(0);
        SK_ISSUE(0, st + 2); __builtin_amdgcn_sched_barrier(0); SK_MMA(1); __builtin_amdgcn_sched_barrier(0);
    }
#undef SK_ISSUE
#undef SK_MMA
#pragma unroll
    for (int j = 0; j < CB; ++j) epi(j, acc[j]);
}
template <int CBT, int CBW, int K, int LDB, class F>
__device__ __forceinline__ void skinny_wg(const bf16* A, int lda, const bf16* Bt, LAS unsigned char* lds, int tid, int jb, int rot, F&& epi) {
    constexpr int U = 8, SK = 32 * U, nst = K / SK, BPITCH = 528, BUFB = CBT * 16 * BPITCH;
    const int lane = tid & 63, i16 = lane & 15, q4 = lane >> 4;
    const bf16* ap = A + (size_t)i16 * lda + 8 * q4;
    const bf16* bg = Bt + (size_t)(tid >> 5) * LDB + (tid & 31) * 8;
    const int bl = (tid >> 5) * BPITCH + (tid & 31) * 16, kofs = (rot * SK) & (K - 1);
    const LAS unsigned char* br = lds + (jb * 16 + i16) * BPITCH + 16 * q4;
    f32x4 acc[CBW];
#pragma unroll
    for (int j = 0; j < CBW; ++j) acc[j] = (f32x4){0.f, 0.f, 0.f, 0.f};
    bf16x8 a[2][U]; v4u breg[CBT];
#define SKG_LOAD(buf, st) do { const int k_ = (((st) < nst ? (st) : nst - 1) * SK + kofs) & (K - 1); \
        _Pragma("unroll") for (int j = 0; j < CBT; ++j) breg[j] = *(const v4u*)(bg + (size_t)(16 * j) * LDB + k_); \
        _Pragma("unroll") for (int u = 0; u < U; ++u) a[buf][u] = *(const bf16x8*)(ap + k_ + 32 * u); } while (0)
    SKG_LOAD(0, 0);
#pragma unroll
    for (int st = 0; st < nst; ++st) {
        const int cb = st & 1;
#pragma unroll
        for (int j = 0; j < CBT; ++j) *(LAS v4u*)(lds + cb * BUFB + j * 16 * BPITCH + bl) = breg[j];
        SKG_LOAD(cb ^ 1, st + 1);
        BAR_LDS();
#pragma unroll
        for (int u = 0; u < U; ++u)
#pragma unroll
            for (int j = 0; j < CBW; ++j) acc[j] = __builtin_amdgcn_mfma_f32_16x16x32_bf16(*(const LAS bf16x8*)(br + cb * BUFB + j * 16 * BPITCH + 64 * u), a[cb][u], acc[j], 0, 0, 0);
    }
#undef SKG_LOAD
#pragma unroll
    for (int j = 0; j < CBW; ++j) epi(j, acc[j]);
}
__device__ __forceinline__ v2u pk4(const f32x4 v) { v2u w; w.x = pk2(v[0], v[1]); w.y = pk2(v[2], v[3]); return w; }

__device__ __forceinline__ bf16x8 afrag(const LAS unsigned char* p) {
    const v2u lo = *(const LAS v2u*)p, hi = *(const LAS v2u*)(p + 16); const v4u r = {lo.x, lo.y, hi.x, hi.y}; return __builtin_bit_cast(bf16x8, r);
}
__device__ __forceinline__ bf16x8 pack_half(const f32x16& X, int sub) {
    v4u r; r.x = pk2(X[8 * sub], X[8 * sub + 1]); r.y = pk2(X[8 * sub + 2], X[8 * sub + 3]); r.z = pk2(X[8 * sub + 4], X[8 * sub + 5]); r.w = pk2(X[8 * sub + 6], X[8 * sub + 7]);
    return __builtin_bit_cast(bf16x8, r);
}
constexpr int PQ_QL = 0, PQ_KL = 17408, PQ_KT = 34816, PQ_VT = 53248, PQ_KK = 90112, PQ_QK = 107520, PQ_LS0 = 124928, PQ_MISC = 142336;
constexpr int QL_PITCH = 272, KT_PITCH = 144, TB_PITCH = 136, KK_PITCH = 68;
__device__ __forceinline__ void gdn_prep_load(const Ctx& C, int unit, int tid, unsigned (&raw)[35], unsigned (&rab)[2]) {
    const int n = unit & 31, hq = (unit >> 5) & 15, b = unit >> 9, tensor = tid >> 7, cp = tid & 63, rh = (tid >> 6) & 1, lane = tid & 63;
    const size_t m0 = (size_t)b * SEQ + (size_t)n * 64;
    const int cidx = (tensor == 0 ? hq * 128 : tensor == 1 ? 2048 + hq * 128 : 4096 + (2 * hq + tensor - 2) * 128) + 2 * cp;
    const bf16* pc = C.P1() + (m0 + rh * 32) * N1P + cidx;
    const bool halo = n > 0 || rh > 0;
#pragma unroll
    for (int i = 0; i < 3; ++i) raw[i] = halo ? *(const unsigned*)(pc - (3 - i) * (ptrdiff_t)N1P) : 0u;
#pragma unroll
    for (int i = 0; i < 32; ++i) raw[3 + i] = *(const unsigned*)(pc + (size_t)i * N1P);
    if (tid < 128) { const bf16* pr = C.P1() + (m0 + lane) * N1P; const int hvw = 2 * hq + (tid >> 6); rab[0] = pr[OFF_A + hvw]; rab[1] = pr[OFF_B + hvw]; }
}
__device__ __forceinline__ void gdn_prep_unit(const Ctx& C, LAS unsigned char* lds, int unit, int next_unit, int tid_in, unsigned (&raw)[35], unsigned (&rab)[2]) {
    int tid = tid_in; asm volatile("" : "+v"(tid));
    const int lane = tid & 63, wave = __builtin_amdgcn_readfirstlane(tid >> 6);
    const int n = unit & 31, hq = (unit >> 5) & 15, b = unit >> 9;
    const int tensor = tid >> 7, ch = tid & 127;
    const size_t m0 = (size_t)b * SEQ + (size_t)n * 64;
    LAS float* KKs = (LAS float*)(lds + PQ_KK); LAS float* QKs = (LAS float*)(lds + PQ_QK); LAS float* Ls0 = (LAS float*)(lds + PQ_LS0);
    LAS float* gcS = (LAS float*)(lds + PQ_MISC); LAS float* betaS = gcS + 128; LAS float* rnq = gcS + 256; LAS float* rnk = gcS + 320;
    LAS float* f1 = gcS + 384;
    if (wave < 2) {
        const int hvw = 2 * hq + wave;
        const float av = bf2f((unsigned short)rab[0]), bv = bf2f((unsigned short)rab[1]);
        const float xx = av + C.dtb()[hvw]; const float sp = xx > 20.f ? xx : log1pf(__expf(xx));
        float g = -__expf(C.alog()[hvw]) * sp;
#pragma unroll
        for (int o = 1; o < 64; o <<= 1) { const float t = __shfl_up(g, o); if (lane >= o) g += t; }
        gcS[wave * 64 + lane] = g; betaS[wave * 64 + lane] = sigmoidf_(bv);
    }
    const int cp = tid & 63, rh = (tid >> 6) & 1;
    float xa[32], xb[32];
    {
        const int cidx = (tensor == 0 ? hq * 128 : tensor == 1 ? 2048 + hq * 128 : 4096 + (2 * hq + tensor - 2) * 128) + 2 * cp;
        const float* cw = C.convw() + cidx;
        const f32x2_t w0 = *(const f32x2_t*)cw, w1 = *(const f32x2_t*)(cw + 8192), w2 = *(const f32x2_t*)(cw + 2 * 8192), w3 = *(const f32x2_t*)(cw + 3 * 8192);
        const unsigned p3 = raw[0], p2 = raw[1], p1 = raw[2];
        float a3 = lo_bf(p3), a2 = lo_bf(p2), a1 = lo_bf(p1), b3 = hi_bf(p3), b2 = hi_bf(p2), b1 = hi_bf(p1);
#pragma unroll
        for (int i = 0; i < 32; ++i) { const unsigned pv = raw[3 + i]; const float ai = lo_bf(pv), bi = hi_bf(pv);
            xa[i] = siluf_(w0.x * a3 + w1.x * a2 + w2.x * a1 + w3.x * ai); xb[i] = siluf_(w0.y * b3 + w1.y * b2 + w2.y * b1 + w3.y * bi);
            a3 = a2; a2 = a1; a1 = ai; b3 = b2; b2 = b1; b1 = bi; }
        if (tensor < 2) {
            LAS unsigned* dst = (LAS unsigned*)(lds + (tensor ? PQ_KL : PQ_QL) + (rh * 32) * QL_PITCH) + cp;
#pragma unroll
            for (int i = 0; i < 32; ++i) dst[i * (QL_PITCH / 4)] = pk2(xa[i], xb[i]);
            if (tensor == 1) { LAS v4u* kta = (LAS v4u*)(lds + PQ_KT + (2 * cp) * KT_PITCH + rh * 64); LAS v4u* ktb = (LAS v4u*)(lds + PQ_KT + (2 * cp + 1) * KT_PITCH + rh * 64);
#pragma unroll
                for (int q = 0; q < 4; ++q) { v4u w; w.x = pk2(xa[8 * q], xa[8 * q + 1]); w.y = pk2(xa[8 * q + 2], xa[8 * q + 3]); w.z = pk2(xa[8 * q + 4], xa[8 * q + 5]); w.w = pk2(xa[8 * q + 6], xa[8 * q + 7]); kta[q] = w;
                    v4u u; u.x = pk2(xb[8 * q], xb[8 * q + 1]); u.y = pk2(xb[8 * q + 2], xb[8 * q + 3]); u.z = pk2(xb[8 * q + 4], xb[8 * q + 5]); u.w = pk2(xb[8 * q + 6], xb[8 * q + 7]); ktb[q] = u; } }
        }
    }
    BAR_LDS();
    if (tensor >= 2) {
        const int e = tensor - 2; const LAS float* be = betaS + e * 64 + rh * 32;
        LAS v4u* vta = (LAS v4u*)(lds + PQ_VT + (e * 128 + 2 * cp) * KT_PITCH + rh * 64); LAS v4u* vtb = (LAS v4u*)(lds + PQ_VT + (e * 128 + 2 * cp + 1) * KT_PITCH + rh * 64);
#pragma unroll
        for (int q = 0; q < 4; ++q) { v4u w; w.x = pk2(xa[8 * q] * be[8 * q], xa[8 * q + 1] * be[8 * q + 1]); w.y = pk2(xa[8 * q + 2] * be[8 * q + 2], xa[8 * q + 3] * be[8 * q + 3]);
            w.z = pk2(xa[8 * q + 4] * be[8 * q + 4], xa[8 * q + 5] * be[8 * q + 5]); w.w = pk2(xa[8 * q + 6] * be[8 * q + 6], xa[8 * q + 7] * be[8 * q + 7]); vta[q] = w;
            v4u u; u.x = pk2(xb[8 * q] * be[8 * q], xb[8 * q + 1] * be[8 * q + 1]); u.y = pk2(xb[8 * q + 2] * be[8 * q + 2], xb[8 * q + 3] * be[8 * q + 3]);
            u.z = pk2(xb[8 * q + 4] * be[8 * q + 4], xb[8 * q + 5] * be[8 * q + 5]); u.w = pk2(xb[8 * q + 6] * be[8 * q + 6], xb[8 * q + 7] * be[8 * q + 7]); vtb[q] = u; }
    }
    {
        const int mat = wave >> 2, ti = (wave >> 1) & 1, tj = wave & 1, c32 = lane & 31, h = lane >> 5;
        const LAS unsigned char* Ab = lds + (mat ? PQ_QL : PQ_KL) + (32 * ti + c32) * QL_PITCH + h * 16;
        const LAS unsigned char* Bb = lds + PQ_KL + (32 * tj + c32) * QL_PITCH + h * 16;
        f32x16 acc;
#pragma unroll
        for (int r = 0; r < 16; ++r) acc[r] = 0.f;
#pragma unroll
        for (int s = 0; s < 8; ++s) { const bf16x8 a = *(const LAS bf16x8*)(Ab + s * 32), bb = *(const LAS bf16x8*)(Bb + s * 32); acc = MFMA32(a, bb, acc); }
        LAS float* Ot = mat ? QKs : KKs;
#pragma unroll
        for (int r = 0; r < 16; ++r) { const int row = 32 * ti + (r & 3) + 8 * (r >> 2) + 4 * h; Ot[row * KK_PITCH + 32 * tj + c32] = acc[r]; }
        if (mat == 0 && ti == tj) {
#pragma unroll
            for (int r = 0; r < 16; ++r) if (((r & 3) + 8 * (r >> 2) + 4 * h) == c32) rnk[32 * ti + c32] = 1.f / sqrtf(acc[r] + 1e-6f);
        }
        if (wave < 2) {
            const LAS unsigned char* Qb = lds + PQ_QL + (32 * wave + c32) * QL_PITCH + h * 16;
            f32x16 qq;
#pragma unroll
            for (int r = 0; r < 16; ++r) qq[r] = 0.f;
#pragma unroll
            for (int s = 0; s < 8; ++s) { const bf16x8 a = *(const LAS bf16x8*)(Qb + s * 32); qq = MFMA32(a, a, qq); }
#pragma unroll
            for (int r = 0; r < 16; ++r) if (((r & 3) + 8 * (r >> 2) + 4 * h) == c32) rnq[32 * wave + c32] = 0.08838834764831845f / sqrtf(qq[r] + 1e-6f);
        }
    }
    BAR_LDS();
    if (tid < 128) { const int e = tid >> 6, i = tid & 63; const float gc = gcS[tid], gl = gcS[e * 64 + 63], eg = __expf(gc);
        f1[tid] = rnq[i] * eg; f1[128 + tid] = rnk[i] * __expf(gl - gc); f1[256 + tid] = betaS[tid] * rnk[i] * eg; }
    BAR_LDS();
    const LAS float* f2 = f1 + 128; const LAS float* f3 = f1 + 256;
    {
        unsigned char* rec0 = C.REC() + (size_t)((b * 32 + 2 * hq) * 32 + n) * REC_BYTES;
#pragma unroll
        for (int r = 0; r < 2; ++r) { const int it = tid + 512 * r, i = it >> 4, j0 = (it & 15) * 4;
            const f32x4 kk4 = *(const LAS f32x4*)(KKs + i * KK_PITCH + j0), qk4 = *(const LAS f32x4*)(QKs + i * KK_PITCH + j0);
            const float rki = rnk[i], rqi = rnq[i], g0i = gcS[i], g1i = gcS[64 + i], b0i = betaS[i], b1i = betaS[64 + i];
            f32x4 l0, l1; float a0[4], a1[4];
#pragma unroll
            for (int t = 0; t < 4; ++t) { const int j = j0 + t; const float rkj = rnk[j];
                const float kk = kk4[t] * rki * rkj, qk = qk4[t] * rqi * rkj, d0 = __expf(g0i - gcS[j]), d1 = __expf(g1i - gcS[64 + j]);
                l0[t] = j < i ? b0i * kk * d0 : 0.f; l1[t] = j < i ? b1i * kk * d1 : 0.f; a0[t] = j <= i ? qk * d0 : 0.f; a1[t] = j <= i ? qk * d1 : 0.f; }
            *(LAS f32x4*)(Ls0 + i * KK_PITCH + j0) = l0; *(LAS f32x4*)(KKs + i * KK_PITCH + j0) = l1;
            v2u w0; w0.x = pk2(a0[0], a0[1]); w0.y = pk2(a0[2], a0[3]); v2u w1; w1.x = pk2(a1[0], a1[1]); w1.y = pk2(a1[2], a1[3]);
            *(v2u*)(rec0 + REC_AT + (i * 64 + j0) * 2) = w0; *(v2u*)(rec0 + (size_t)32 * REC_BYTES + REC_AT + (i * 64 + j0) * 2) = w1; }
#pragma unroll
        for (int r = 0; r < 4; ++r) { const int it = tid + 512 * r, e = it >> 10, rem = it & 1023, i = rem >> 4, d8 = rem & 15;
            const v4u qv = *(const LAS v4u*)(lds + PQ_QL + i * QL_PITCH + d8 * 16); const float sc = f1[e * 64 + i];
            v4u w; w.x = pk2(lo_bf(qv.x) * sc, hi_bf(qv.x) * sc); w.y = pk2(lo_bf(qv.y) * sc, hi_bf(qv.y) * sc); w.z = pk2(lo_bf(qv.z) * sc, hi_bf(qv.z) * sc); w.w = pk2(lo_bf(qv.w) * sc, hi_bf(qv.w) * sc);
            *(v4u*)(rec0 + (size_t)e * 32 * REC_BYTES + REC_QD + i * 256 + d8 * 16) = w; }
#pragma unroll
        for (int r = 0; r < 4; ++r) { const int it = tid + 512 * r, e = it >> 10, rem = it & 1023, d = rem >> 3, i8 = rem & 7;
            const v4u kv = *(const LAS v4u*)(lds + PQ_KT + d * KT_PITCH + i8 * 16); const LAS float* sc = f2 + e * 64 + 8 * i8;
            v4u w; w.x = pk2(lo_bf(kv.x) * sc[0], hi_bf(kv.x) * sc[1]); w.y = pk2(lo_bf(kv.y) * sc[2], hi_bf(kv.y) * sc[3]); w.z = pk2(lo_bf(kv.z) * sc[4], hi_bf(kv.z) * sc[5]); w.w = pk2(lo_bf(kv.w) * sc[6], hi_bf(kv.w) * sc[7]);
            *(v4u*)(rec0 + (size_t)e * 32 * REC_BYTES + REC_KDT + d * 128 + i8 * 16) = w; }
        if (tid < 2) C.GL()[(b * 32 + 2 * hq + tid) * 32 + n] = __expf(gcS[tid * 64 + 63]);
    }
    BAR_LDS();
    if (next_unit >= 0) gdn_prep_load(C, next_unit, tid, raw, rab);
    if (wave < 2) {
        const int c32 = lane & 31, hb = lane >> 5;
        const LAS float* Lm = wave ? KKs : Ls0;
        const LAS float* L = Lm + (hb * 32) * KK_PITCH + hb * 32;
        float t[32];
#pragma unroll
        for (int i = 0; i < 32; ++i) {
            float s0 = (i == c32) ? 1.f : 0.f, s1 = 0.f, s2 = 0.f, s3 = 0.f;
#pragma unroll
            for (int j4 = 0; j4 < (i + 3) / 4; ++j4) { const f32x4 l = *(const LAS f32x4*)(L + i * KK_PITCH + 4 * j4);
                if (4 * j4 + 0 < i) s0 -= l.x * t[4 * j4 + 0];
                if (4 * j4 + 1 < i) s1 -= l.y * t[4 * j4 + 1];
                if (4 * j4 + 2 < i) s2 -= l.z * t[4 * j4 + 2];
                if (4 * j4 + 3 < i) s3 -= l.w * t[4 * j4 + 3]; }
            t[i] = (s0 + s1) + (s2 + s3);
        }
        const float sc = f3[wave * 64 + lane];
        LAS unsigned char* T1base = lds + PQ_QL + wave * 8704; LAS unsigned char* T2base = lds + PQ_QK + wave * 8704;
        {
            LAS bf16* T1 = (LAS bf16*)(T1base + (hb * 32) * TB_PITCH) + lane; LAS bf16* T2 = (LAS bf16*)(T2base + (hb * 32) * TB_PITCH) + lane;
#pragma unroll
            for (int i = 0; i < 32; ++i) { T1[i * (TB_PITCH / 2)] = f2bf(t[i]); T2[i * (TB_PITCH / 2)] = f2bf(t[i] * sc); }
            if (hb) { LAS bf16* Z1 = (LAS bf16*)T1base + lane; LAS bf16* Z2 = (LAS bf16*)T2base + lane;
#pragma unroll
                for (int i = 0; i < 32; ++i) { Z1[i * (TB_PITCH / 2)] = 0; Z2[i * (TB_PITCH / 2)] = 0; } }
        }
        if (!hb) { LAS v4u* tt = (LAS v4u*)((LAS unsigned char*)Lm + c32 * (KK_PITCH * 4) + 128);
#pragma unroll
            for (int q = 0; q < 4; ++q) { v4u w; w.x = pk2(t[8 * q], t[8 * q + 1]); w.y = pk2(t[8 * q + 2], t[8 * q + 3]); w.z = pk2(t[8 * q + 4], t[8 * q + 5]); w.w = pk2(t[8 * q + 6], t[8 * q + 7]); tt[q] = w; } }
        f32x16 M;
#pragma unroll
        for (int r = 0; r < 16; ++r) M[r] = 0.f;
#pragma unroll
        for (int s2 = 0; s2 < 2; ++s2) {
            const LAS f32x4* lp = (const LAS f32x4*)(Lm + (32 + c32) * KK_PITCH + 16 * s2 + 8 * hb); const f32x4 la = lp[0], lb = lp[1];
            v4u av; av.x = pk2(la.x, la.y); av.y = pk2(la.z, la.w); av.z = pk2(lb.x, lb.y); av.w = pk2(lb.z, lb.w);
            const bf16x8 bv = *(const LAS bf16x8*)((const LAS unsigned char*)Lm + c32 * (KK_PITCH * 4) + 128 + (16 * s2 + 8 * hb) * 2);
            M = MFMA32(__builtin_bit_cast(bf16x8, av), bv, M); }
        f32x16 T21;
#pragma unroll
        for (int r = 0; r < 16; ++r) T21[r] = 0.f;
#pragma unroll
        for (int s2 = 0; s2 < 2; ++s2) T21 = MFMA32(afrag(T1base + (32 + c32) * TB_PITCH + (32 + 16 * s2 + 4 * hb) * 2), pack_half(M, s2), T21);
        {   const float sc21 = f3[wave * 64 + c32];
            LAS bf16* T1 = (LAS bf16*)(T1base + (32 + 4 * hb) * TB_PITCH) + c32; LAS bf16* T2 = (LAS bf16*)(T2base + (32 + 4 * hb) * TB_PITCH) + c32;
#pragma unroll
            for (int r = 0; r < 16; ++r) { const int ro = ((r & 3) + 8 * (r >> 2)) * (TB_PITCH / 2); T1[ro] = f2bf(-T21[r]); T2[ro] = f2bf(-T21[r] * sc21); } }
    }
    BAR_LDS();
    {
        const int e = wave >> 2, ct = wave & 3, c32 = lane & 31, h = lane >> 5;
        unsigned char* rec = C.REC() + (size_t)((b * 32 + 2 * hq + e) * 32 + n) * REC_BYTES;
        const LAS unsigned char* Bv = lds + PQ_VT + (e * 128 + 32 * ct + c32) * KT_PITCH + h * 16;
        const LAS unsigned char* Bk = lds + PQ_KT + (32 * ct + c32) * KT_PITCH + h * 16;
#pragma unroll
        for (int t = 0; t < 2; ++t) {
            const LAS unsigned char* A1 = lds + PQ_QL + e * 8704 + (32 * t + c32) * TB_PITCH + h * 16;
            const LAS unsigned char* A2 = lds + PQ_QK + e * 8704 + (32 * t + c32) * TB_PITCH + h * 16;
            f32x16 au, aw;
#pragma unroll
            for (int r = 0; r < 16; ++r) { au[r] = 0.f; aw[r] = 0.f; }
#pragma unroll
            for (int s = 0; s < 4; ++s) {
                const v2u a1l = *(const LAS v2u*)(A1 + s * 32), a1h = *(const LAS v2u*)(A1 + s * 32 + 8), a2l = *(const LAS v2u*)(A2 + s * 32), a2h = *(const LAS v2u*)(A2 + s * 32 + 8);
                const v4u a1 = {a1l.x, a1l.y, a1h.x, a1h.y}, a2 = {a2l.x, a2l.y, a2h.x, a2h.y};
                au = MFMA32(__builtin_bit_cast(bf16x8, a1), *(const LAS bf16x8*)(Bv + s * 32), au);
                aw = MFMA32(*(const LAS bf16x8*)(Bk + s * 32), __builtin_bit_cast(bf16x8, a2), aw); }
            unsigned char* ut = rec + REC_UT + (32 * ct + c32) * 128 + (32 * t + 4 * h) * 2;
#pragma unroll
            for (int g4 = 0; g4 < 4; ++g4) { v2u w; w.x = pk2(au[4 * g4], au[4 * g4 + 1]); w.y = pk2(au[4 * g4 + 2], au[4 * g4 + 3]); *(v2u*)(ut + 16 * g4) = w; }
            unsigned char* wn = rec + REC_WN + ((32 * t + c32) * 128 + 32 * ct + 4 * h) * 2;
#pragma unroll
            for (int g4 = 0; g4 < 4; ++g4) { v2u w; w.x = pk2(-aw[4 * g4], -aw[4 * g4 + 1]); w.y = pk2(-aw[4 * g4 + 2], -aw[4 * g4 + 3]); *(v2u*)(wn + 16 * g4) = w; }
        }
    }
    BAR_LDS();
}
__device__ __forceinline__ void phase2(const Ctx& C, LAS unsigned char* lds) {
    {   const int tid = fresh_tid(); unsigned raw[35], rab[2] = {0u, 0u};
        if ((int)blockIdx.x < NB * 16 * 32) gdn_prep_load(C, blockIdx.x, tid, raw, rab);
#pragma unroll 1
        for (int u = blockIdx.x; u < NB * 16 * 32; u += gridDim.x) { const int nu = u + (int)gridDim.x; gdn_prep_unit(C, lds, u, nu < NB * 16 * 32 ? nu : -1, tid, raw, rab); } }
    const int gt = blockIdx.x * 512 + fresh_tid(), NGT = gridDim.x * 512;
    for (int i = gt; i < (NB * 3 + NSMP) * 4096; i += NGT) { const int rr = i >> 12, c2 = i & 4095;
        size_t m; float* dst;
        if (rr < NB * 3) { const int b = rr / 3, r = rr % 3; m = (size_t)b * SEQ + SEQ - 3 + r; dst = C.out() + O_CONVP + (size_t)rr * 8192; }
        else { const int b = rr - NB * 3; m = TP + b; dst = C.out() + O_CONVS + ((size_t)b * 3 + 2) * 8192; }
        const unsigned v = *(const unsigned*)(C.P1() + m * N1P + 2 * c2);
        f32x2_t o = {lo_bf(v), hi_bf(v)}; *(f32x2_t*)(dst + 2 * c2) = o; }
}

constexpr int SC_SLOT = 62464, SC_WNQD = 0, SC_ATK = 34816, SC_OBUF = 2 * SC_SLOT, SC_PITCH_A = 272, SC_PITCH_B = 144;
__device__ __forceinline__ void gdn_scan_unit(const Ctx& C, LAS unsigned char* lds, int bh) {
    const int tid = fresh_tid(), lane = tid & 63, wave = __builtin_amdgcn_readfirstlane(tid >> 6), c32 = lane & 31, h = lane >> 5;
    const int b = bh >> 5, hv = bh & 31;
    const unsigned char* rec0 = C.REC() + (size_t)bh * 32 * REC_BYTES;
    f32x16 S[4];
#pragma unroll
    for (int T = 0; T < 4; ++T)
#pragma unroll
        for (int r = 0; r < 16; ++r) S[T][r] = 0.f;
    const int lt = tid & 255;
    const int ldA = SC_WNQD + (lt >> 4) * SC_PITCH_A + (lt & 15) * 16, ldB = SC_ATK + (lt >> 3) * SC_PITCH_B + (lt & 7) * 16;
    if (wave >= 4) {
#pragma unroll
        for (int r = 0; r < 14; ++r) { const v4u v = *(const v4u*)(rec0 + 16 * lt + 4096 * r);
            *(LAS v4u*)(lds + (r < 8 ? ldA + r * 16 * SC_PITCH_A : ldB + (r - 8) * 32 * SC_PITCH_B)) = v; } }
    BAR_LDS();
    for (int n = 0; n < 32; ++n) {
        const unsigned char* rec = rec0 + (size_t)n * REC_BYTES;
        const LAS unsigned char* slot = lds + (n & 1) * SC_SLOT;
        const int ntok = tid >> 3, nseg = tid & 7; const size_t nm = (size_t)b * SEQ + n * 64 + ntok;
        const v4u* zp = (const v4u*)(C.P1() + nm * N1P + NZ + hv * 128 + nseg * 16); const v4u z0 = zp[0], z1 = zp[1];
        if (wave >= 4) {
            if (n < 31) { const unsigned char* nrec = rec + REC_BYTES; LAS unsigned char* ns = lds + ((n + 1) & 1) * SC_SLOT;
                v4u v[14];
#pragma unroll
                for (int r = 0; r < 14; ++r) v[r] = *(const v4u*)(nrec + 16 * lt + 4096 * r);
#pragma unroll
                for (int r = 0; r < 14; ++r) *(LAS v4u*)(ns + (r < 8 ? ldA + r * 16 * SC_PITCH_A : ldB + (r - 8) * 32 * SC_PITCH_B)) = v[r]; }
        } else {
            __builtin_amdgcn_s_setprio(1);
            const int dv = 32 * wave + c32;
            f32x16 V[2], O[2];
            {
                const unsigned char* ut = rec + REC_UT + dv * 128 + h * 8;
#pragma unroll
                for (int t = 0; t < 2; ++t)
#pragma unroll
                    for (int g4 = 0; g4 < 4; ++g4) { const v2u w = *(const v2u*)(ut + (32 * t + 8 * g4) * 2);
                        V[t][4 * g4 + 0] = lo_bf(w.x); V[t][4 * g4 + 1] = hi_bf(w.x); V[t][4 * g4 + 2] = lo_bf(w.y); V[t][4 * g4 + 3] = hi_bf(w.y); }
#pragma unroll
                for (int t = 0; t < 2; ++t)
#pragma unroll
                    for (int r = 0; r < 16; ++r) O[t][r] = 0.f;
            }
            const float gl = C.GL()[bh * 32 + n];
            const LAS unsigned char* aW = slot + SC_WNQD + c32 * SC_PITCH_A + h * 8;
            const LAS unsigned char* aK = slot + SC_ATK + c32 * SC_PITCH_B + h * 8;
#pragma unroll
            for (int s = 0; s < 8; ++s) { const bf16x8 sb = pack_half(S[s >> 1], s & 1);
                V[0] = MFMA32(afrag(aW + s * 32), sb, V[0]);
                V[1] = MFMA32(afrag(aW + 32 * SC_PITCH_A + s * 32), sb, V[1]);
                O[0] = MFMA32(afrag(aW + 64 * SC_PITCH_A + s * 32), sb, O[0]);
                O[1] = MFMA32(afrag(aW + 96 * SC_PITCH_A + s * 32), sb, O[1]); __builtin_amdgcn_sched_barrier(0); }
#pragma unroll
            for (int T = 0; T < 4; ++T) S[T] = S[T] * gl;
#pragma unroll
            for (int s = 0; s < 4; ++s) { const bf16x8 vb = pack_half(V[s >> 1], s & 1);
                O[0] = MFMA32(afrag(aK + s * 32), vb, O[0]);
                O[1] = MFMA32(afrag(aK + 32 * SC_PITCH_B + s * 32), vb, O[1]);
#pragma unroll
                for (int T = 0; T < 4; ++T) S[T] = MFMA32(afrag(aK + (64 + 32 * T) * SC_PITCH_B + s * 32), vb, S[T]);
                __builtin_amdgcn_sched_barrier(0); }
            LAS bf16* ob = (LAS bf16*)(lds + SC_OBUF) + dv;
#pragma unroll
            for (int t = 0; t < 2; ++t)
#pragma unroll
                for (int r = 0; r < 16; ++r) { const int tok = 32 * t + (r & 3) + 8 * (r >> 2) + 4 * h; ob[tok * (SC_PITCH_A / 2)] = f2bf(O[t][r]); }
            __builtin_amdgcn_s_setprio(0);
        }
        BAR_LDS();
        {
            const int tok = ntok, seg = nseg; const size_t m = nm;
            const LAS v4u* op = (const LAS v4u*)(lds + SC_OBUF + tok * SC_PITCH_A + seg * 32);
            const v4u o0 = op[0], o1 = op[1];
            float o[16] = {lo_bf(o0.x), hi_bf(o0.x), lo_bf(o0.y), hi_bf(o0.y), lo_bf(o0.z), hi_bf(o0.z), lo_bf(o0.w), hi_bf(o0.w),
                           lo_bf(o1.x), hi_bf(o1.x), lo_bf(o1.y), hi_bf(o1.y), lo_bf(o1.z), hi_bf(o1.z), lo_bf(o1.w), hi_bf(o1.w)};
            float ss = 0.f;
#pragma unroll
            for (int i = 0; i < 16; ++i) ss += o[i] * o[i];
            ss += __shfl_xor(ss, 1); ss += __shfl_xor(ss, 2); ss += __shfl_xor(ss, 4);
            const float rs = 1.f / sqrtf(ss * (1.f / 128.f) + RMS_EPS);
            const float z[16] = {lo_bf(z0.x), hi_bf(z0.x), lo_bf(z0.y), hi_bf(z0.y), lo_bf(z0.z), hi_bf(z0.z), lo_bf(z0.w), hi_bf(z0.w),
                                 lo_bf(z1.x), hi_bf(z1.x), lo_bf(z1.y), hi_bf(z1.y), lo_bf(z1.z), hi_bf(z1.z), lo_bf(z1.w), hi_bf(z1.w)};
            const float* gn = C.onorm() + seg * 16;
            float y[16];
#pragma unroll
            for (int i = 0; i < 16; ++i) y[i] = o[i] * rs * gn[i] * siluf_(z[i]);
            v4u w0, w1; w0.x = pk2(y[0], y[1]); w0.y = pk2(y[2], y[3]); w0.z = pk2(y[4], y[5]); w0.w = pk2(y[6], y[7]);
            w1.x = pk2(y[8], y[9]); w1.y = pk2(y[10], y[11]); w1.z = pk2(y[12], y[13]); w1.w = pk2(y[14], y[15]);
            v4u* og = (v4u*)(C.OG() + m * E + hv * 128 + seg * 16); og[0] = w0; og[1] = w1;
        }
        BAR_LDS();
    }
    if (wave < 4) {
        float* dp = C.out() + O_DELTAP + (size_t)bh * 16384 + 32 * wave + c32;
#pragma unroll
        for (int T = 0; T < 4; ++T)
#pragma unroll
            for (int r = 0; r < 16; ++r) { const int dk = 32 * T + (r & 3) + 8 * (r >> 2) + 4 * h; __builtin_nontemporal_store(S[T][r], dp + dk * 128); }
    }
}

__device__ __forceinline__ void gdn_sample_unit(const Ctx& C, LAS unsigned char* lds, int unit) {
    const int tid = fresh_tid(), lane = tid & 63, wave = tid >> 6;
    const int b = unit >> 5, hv = unit & 31, hq = hv >> 1; const size_t m = TP + b;
    LAS float* sv = (LAS float*)lds;
    LAS float* part = (LAS float*)(lds + 2048);
    LAS float* misc = (LAS float*)(lds + 2048 + 8192);
    const bf16* pr = C.P1() + m * N1P;
    const int dv4 = tid & 31, dk0 = tid >> 5;
    const f32x4* Sp = (const f32x4*)(C.ds() + (size_t)unit * 16384) + dv4;
    f32x4 S[8];
#pragma unroll
    for (int r = 0; r < 8; ++r) S[r] = __builtin_nontemporal_load(Sp + (dk0 + 16 * r) * 32);
    if (tid < 384) { const int tensor = tid >> 7, ch = tid & 127;
        const int cidx = tensor == 0 ? hq * 128 + ch : tensor == 1 ? 2048 + hq * 128 + ch : 4096 + hv * 128 + ch;
        const float* st = C.cs() + (size_t)b * 3 * 8192 + cidx;
        const float y = C.convw()[cidx] * st[0] + C.convw()[8192 + cidx] * st[8192] + C.convw()[2 * 8192 + cidx] * st[2 * 8192] + C.convw()[3 * 8192 + cidx] * bf2f(pr[cidx]);
        sv[tid] = siluf_(y); }
    BAR_LDS();
    if (wave < 2) { const float a0 = sv[wave * 128 + lane], a1 = sv[wave * 128 + 64 + lane]; float rn = 1.f / sqrtf(wave_sum(a0 * a0 + a1 * a1) + 1e-6f);
        if (wave == 0) rn *= 0.08838834764831845f;
        sv[wave * 128 + lane] = a0 * rn; sv[wave * 128 + 64 + lane] = a1 * rn; }
    BAR_LDS();
    if (wave == 0) { const float qk = wave_sum(sv[lane] * sv[128 + lane] + sv[64 + lane] * sv[192 + lane]); if (lane == 0) misc[0] = qk; }
    const float av = bf2f(pr[OFF_A + hv]), bv = bf2f(pr[OFF_B + hv]);
    const float xx = av + C.dtb()[hv]; const float sp = xx > 20.f ? xx : log1pf(__expf(xx));
    const float eg = __expf(-__expf(C.alog()[hv]) * sp), beta = sigmoidf_(bv);
    f32x4 ks = {0.f, 0.f, 0.f, 0.f}, qs = {0.f, 0.f, 0.f, 0.f};
#pragma unroll
    for (int r = 0; r < 8; ++r) { const float qd = sv[dk0 + 16 * r], kd = sv[128 + dk0 + 16 * r]; ks += S[r] * kd; qs += S[r] * qd; }
#pragma unroll
    for (int i = 0; i < 4; ++i) { ks[i] += __shfl_xor(ks[i], 32); qs[i] += __shfl_xor(qs[i], 32); }
    if (lane < 32) { *(LAS f32x4*)(part + wave * 128 + 4 * dv4) = ks; *(LAS f32x4*)(part + 1024 + wave * 128 + 4 * dv4) = qs; }
    BAR_LDS();
    ks = (f32x4){0.f, 0.f, 0.f, 0.f}; qs = ks;
#pragma unroll
    for (int w = 0; w < 8; ++w) { ks += *(const LAS f32x4*)(part + w * 128 + 4 * dv4); qs += *(const LAS f32x4*)(part + 1024 + w * 128 + 4 * dv4); }
    const f32x4 vv = *(const LAS f32x4*)(sv + 256 + 4 * dv4); const float qk = misc[0];
    const f32x4 vn = (vv - ks * eg) * beta;
    const f32x4 o = qs * eg + vn * qk;
    f32x4* So = (f32x4*)(C.out() + O_DELTAS + (size_t)unit * 16384) + dv4;
#pragma unroll
    for (int r = 0; r < 8; ++r) { const float kd = sv[128 + dk0 + 16 * r]; __builtin_nontemporal_store(S[r] * eg + vn * kd, So + (dk0 + 16 * r) * 32); }
    if (wave == 0) {
        float ss = o.x * o.x + o.y * o.y + o.z * o.z + o.w * o.w;
        ss += __shfl_xor(ss, 1); ss += __shfl_xor(ss, 2); ss += __shfl_xor(ss, 4); ss += __shfl_xor(ss, 8); ss += __shfl_xor(ss, 16);
        const float rs = 1.f / sqrtf(ss * (1.f / 128.f) + RMS_EPS);
        if (lane < 32) { const v2u zv = *(const v2u*)(pr + NZ + hv * 128 + 4 * dv4); const f32x4 gn = *(const f32x4*)(C.onorm() + 4 * dv4);
            v2u w; w.x = pk2(o.x * rs * gn.x * siluf_(lo_bf(zv.x)), o.y * rs * gn.y * siluf_(hi_bf(zv.x)));
            w.y = pk2(o.z * rs * gn.z * siluf_(lo_bf(zv.y)), o.w * rs * gn.w * siluf_(hi_bf(zv.y)));
            *(v2u*)(C.OG() + m * E + hv * 128 + 4 * dv4) = w; } }
    BAR_LDS();
}
__device__ __forceinline__ void phase3(const Ctx& C, LAS unsigned char* lds) {
    for (int bh = blockIdx.x; bh < NB * 32; bh += gridDim.x) gdn_scan_unit(C, lds, bh);
    LAS int* qslot = (LAS int*)(lds + 16384); const int qt = fresh_tid();
    for (;;) {
        if (qt == 0) *qslot = (int)atomicAdd(C.ctl() + 0, 1u);
        BAR_LDS();
        const int u = *qslot;
        BAR_LDS();
        if (u >= NSMP * 32) break;
        gdn_sample_unit(C, lds, u);
    }
}

constexpr int SS_SLOT = 36864, SS_HS = 17408, SS_HSB = 8704, SS_UL = 34816, SS_HS_PITCH = 272, SS_BU_PITCH = 272;
template <bool SAMPLE>
__device__ __forceinline__ void ssm_round(const Ctx& C, LAS unsigned char* lds, int ubase, int tid) {
    const int lane = tid & 63, wave = __builtin_amdgcn_readfirstlane(tid >> 6), slot = wave & 3, role = wave >> 2;
    const int u = ubase + slot, seq = u >> 8, g = u & 255;
    LAS unsigned char* wl = lds + slot * SS_SLOT;
    const int c32 = lane & 31, h = lane >> 5, c16 = lane & 15, q4 = lane >> 4;
    constexpr int nchunk = SAMPLE ? NSMP / 32 : SEQ / 32;
    const size_t mbase = SAMPLE ? (size_t)TP : (size_t)seq * SEQ;
    if (role == 0) {
        bf16x8 bb[4];
#pragma unroll
        for (int j = 0; j < 4; ++j) bb[j] = *(const bf16x8*)(C.BBT() + ((size_t)g * 128 + 32 * j + c32) * 16 + 8 * h);
        const float ar = C.AR()[g * 64 + lane], ai = C.AI()[g * 64 + lane];
        const f32x2_t A2 = {ar, ar}, B2 = {-ai, ai}; f32x2_t h2 = {0.f, 0.f};
        __builtin_amdgcn_s_setprio(1);
        const bf16* up = C.UZ() + (mbase + c32) * NZ + g * 16 + 8 * h;
        bf16x8 ring[4];
#pragma unroll
        for (int i = 0; i < 4; ++i) ring[i] = __builtin_nontemporal_load((const bf16x8*)(up + (size_t)i * 32 * NZ));
#pragma unroll 1
        for (int ck0 = 0; ck0 < nchunk; ck0 += 4) {
#pragma unroll
            for (int ci = 0; ci < 4; ++ci) { const int ck = ck0 + ci;
                const bf16x8 ua = ring[ci];
                ring[ci] = __builtin_nontemporal_load((const bf16x8*)(up + (size_t)(ck + 4 < nchunk ? ck + 4 : nchunk - 1) * 32 * NZ));
                LAS unsigned char* HS = wl + SS_HS + (ck & 1) * SS_HSB;
                *(LAS bf16x8*)(wl + SS_UL + (ck & 1) * 1024 + c32 * 32 + h * 16) = ua;
#pragma unroll
                for (int j2 = 0; j2 < 2; ++j2) { f32x16 aR, aI;
#pragma unroll
                    for (int r = 0; r < 16; ++r) { aR[r] = 0.f; aI[r] = 0.f; }
                    aR = MFMA32(ua, bb[j2], aR); aI = MFMA32(ua, bb[2 + j2], aI);
                    LAS unsigned char* bp = wl + (32 * j2 + c32) * SS_BU_PITCH + h * 32;
#pragma unroll
                    for (int g4 = 0; g4 < 4; ++g4)
#pragma unroll
                        for (int hh = 0; hh < 2; ++hh) { const int r0 = 4 * g4 + 2 * hh; const f32x4 v = {aR[r0], aI[r0], aR[r0 + 1], aI[r0 + 1]};
                            *(LAS f32x4*)(bp + (4 * g4 + hh) * 16) = v; } }
                {
                    const LAS unsigned char* rp = wl + lane * SS_BU_PITCH;
#pragma unroll
                    for (int q = 0; q < 16; ++q) { const f32x4 v = *(const LAS f32x4*)(rp + q * 16);
                        f32x2_t n0 = A2 * h2 + (B2 * __builtin_shufflevector(h2, h2, 1, 0) + (f32x2_t){v.x, v.y});
                        *(LAS unsigned*)(HS + (2 * q) * SS_HS_PITCH + lane * 4) = pk2(n0.x, n0.y);
                        f32x2_t n1 = A2 * n0 + (B2 * __builtin_shufflevector(n0, n0, 1, 0) + (f32x2_t){v.z, v.w});
                        *(LAS unsigned*)(HS + (2 * q + 1) * SS_HS_PITCH + lane * 4) = pk2(n1.x, n1.y);
                        h2 = n1; }
                }
                BAR_LDS();
            }
        }
        BAR_LDS();
        __builtin_amdgcn_s_setprio(0);
        if (!SAMPLE) { C.out()[O_REP + ((size_t)seq * 256 + g) * 64 + lane] = h2.x; C.out()[O_IMP + ((size_t)seq * 256 + g) * 64 + lane] = h2.y; }
    } else {
        bf16x8 cm[4];
#pragma unroll
        for (int s = 0; s < 4; ++s) cm[s] = *(const bf16x8*)(C.CMT() + ((size_t)g * 16 + c16) * 128 + 32 * s + 8 * q4);
        const float dsk = C.dssm()[g * 16 + c16];
        bf16* ygw = C.YG() + (mbase + (lane >> 1)) * E + g * 16 + (lane & 1) * 8;
        BAR_LDS();
#pragma unroll 1
        for (int cc = 0; cc < nchunk; ++cc) {
            {
                const LAS unsigned char* HS = wl + SS_HS + (cc & 1) * SS_HSB; const LAS unsigned char* UL = wl + SS_UL + (cc & 1) * 1024;
                LAS unsigned char* YL = wl + SS_HS + (cc & 1) * SS_HSB;
#pragma unroll
                for (int tt = 0; tt < 2; ++tt) { f32x4 y = {0.f, 0.f, 0.f, 0.f};
#pragma unroll
                    for (int s = 0; s < 4; ++s) { const bf16x8 a = *(const LAS bf16x8*)(HS + (16 * tt + c16) * SS_HS_PITCH + s * 64 + q4 * 16);
                        y = __builtin_amdgcn_mfma_f32_16x16x32_bf16(a, cm[s], y, 0, 0, 0); }
#pragma unroll
                    for (int r = 0; r < 4; ++r) { const int row = 16 * tt + 4 * q4 + r;
                        const float uv = bf2f(*(const LAS bf16*)(UL + row * 32 + c16 * 2));
                        *(LAS bf16*)(YL + row * 32 + c16 * 2) = f2bf(gelu_tanh(y[r] + dsk * uv)); } }
                *(v4u*)(ygw + (size_t)(cc * 32) * E) = *(const LAS v4u*)(YL + lane * 16); }
            BAR_LDS();
        }
    }
}
__device__ __forceinline__ void ssm_sample_unit(const Ctx& C, LAS unsigned char* wl, int g, int rb, int lane_in) {
    int lane = lane_in; asm volatile("" : "+v"(lane));
    const int c32 = lane & 31, h = lane >> 5, c16 = lane & 15, q4 = lane >> 4;
    const size_t m0 = (size_t)TP + rb * 32;
    const size_t sbase = ((size_t)(rb * 32) * 256 + g) * 64;
    const float* pr = C.sre() + sbase; const float* pi = C.sim() + sbase;
    float h0r[16], h0i[16];
#pragma unroll
    for (int r = 0; r < 16; ++r) { h0r[r] = __builtin_nontemporal_load((const float*)((const char*)pr + (unsigned)(r * 65536 + lane * 4))); h0i[r] = __builtin_nontemporal_load((const float*)((const char*)pi + (unsigned)(r * 65536 + lane * 4))); }
    const bf16x8 ua = *(const bf16x8*)(C.UZ() + (m0 + c32) * NZ + g * 16 + 8 * h);
    bf16x8 bb[4], cm[4];
#pragma unroll
    for (int j = 0; j < 4; ++j) bb[j] = *(const bf16x8*)(C.BBT() + ((size_t)g * 128 + 32 * j + c32) * 16 + 8 * h);
#pragma unroll
    for (int s = 0; s < 4; ++s) cm[s] = *(const bf16x8*)(C.CMT() + ((size_t)g * 16 + c16) * 128 + 32 * s + 8 * q4);
    const float ar = C.AR()[g * 64 + lane], ai = C.AI()[g * 64 + lane], dsk = C.dssm()[g * 16 + c16];
    LAS unsigned char* HS = wl + SS_HS; LAS unsigned char* UL = wl + SS_UL;
    *(LAS bf16x8*)(UL + c32 * 32 + h * 16) = ua;
#pragma unroll
    for (int j2 = 0; j2 < 2; ++j2) { f32x16 aR, aI;
#pragma unroll
        for (int r = 0; r < 16; ++r) { aR[r] = 0.f; aI[r] = 0.f; }
        aR = MFMA32(ua, bb[j2], aR); aI = MFMA32(ua, bb[2 + j2], aI);
        LAS unsigned char* bp = wl + (32 * j2 + c32) * SS_BU_PITCH + h * 32;
#pragma unroll
        for (int g4 = 0; g4 < 4; ++g4)
#pragma unroll
            for (int hh = 0; hh < 2; ++hh) { const int r0 = 4 * g4 + 2 * hh; const f32x4 v = {aR[r0], aI[r0], aR[r0 + 1], aI[r0 + 1]};
                *(LAS f32x4*)(bp + (4 * g4 + hh) * 16) = v; } }
    float* orp = C.out() + O_RES + sbase; float* oip = C.out() + O_IMS + sbase;
    const LAS unsigned char* rp = wl + lane * SS_BU_PITCH;
#pragma unroll
    for (int q = 0; q < 16; ++q) { const f32x4 v = *(const LAS f32x4*)(rp + q * 16);
        if (q == 8) {
#pragma unroll
            for (int r = 0; r < 16; ++r) { h0r[r] = *(const float*)((const char*)pr + (unsigned)((16 + r) * 65536 + lane * 4)); h0i[r] = *(const float*)((const char*)pi + (unsigned)((16 + r) * 65536 + lane * 4)); } }
#pragma unroll
        for (int e = 0; e < 2; ++e) { const int r = 2 * q + e; const float re = e ? v.z : v.x, im = e ? v.w : v.y;
            const float nr = ar * h0r[r & 15] - ai * h0i[r & 15] + re, ni = ar * h0i[r & 15] + ai * h0r[r & 15] + im;
            __builtin_nontemporal_store(nr, (float*)((char*)orp + (unsigned)(r * 65536 + lane * 4))); __builtin_nontemporal_store(ni, (float*)((char*)oip + (unsigned)(r * 65536 + lane * 4)));
            *(LAS unsigned*)(HS + r * SS_HS_PITCH + lane * 4) = pk2(nr, ni); } }
    bf16* yg = C.YG() + (m0 + 4 * q4) * E + g * 16 + c16;
#pragma unroll
    for (int tt = 0; tt < 2; ++tt) { f32x4 y = {0.f, 0.f, 0.f, 0.f};
#pragma unroll
        for (int s = 0; s < 4; ++s) { const bf16x8 a = *(const LAS bf16x8*)(HS + (16 * tt + c16) * SS_HS_PITCH + s * 64 + q4 * 16);
            y = __builtin_amdgcn_mfma_f32_16x16x32_bf16(a, cm[s], y, 0, 0, 0); }
#pragma unroll
        for (int r = 0; r < 4; ++r) { const int row = 16 * tt + 4 * q4 + r;
            const float uv = bf2f(*(const LAS bf16*)(UL + row * 32 + c16 * 2));
            yg[(size_t)(16 * tt + r) * E] = f2bf(gelu_tanh(y[r] + dsk * uv)); } }
}
__device__ __forceinline__ void phase7(const Ctx& C, LAS unsigned char* lds) {
    const int tid = fresh_tid();
    for (int ub = blockIdx.x * 4; ub < NB * 256; ub += gridDim.x * 4) ssm_round<false>(C, lds, ub, tid);
    const int lane = tid & 63, wave = __builtin_amdgcn_readfirstlane(tid >> 6);
    if (wave < 4) for (int u = blockIdx.x * 4 + wave; u < 1024; u += gridDim.x * 4) ssm_sample_unit(C, lds + wave * SS_SLOT, u & 255, u >> 8, lane);
}
__device__ __forceinline__ void grid_bar(unsigned* cnt, unsigned target) {
    __syncthreads();
    if (threadIdx.x == 0) {
        __builtin_amdgcn_fence(__ATOMIC_RELEASE, "agent");
        asm volatile("s_waitcnt vmcnt(0)" ::: "memory");
        __hip_atomic_fetch_add(cnt, 1u, __ATOMIC_RELAXED, __HIP_MEMORY_SCOPE_AGENT);
        unsigned spins = 0;
        while (__hip_atomic_load(cnt, __ATOMIC_RELAXED, __HIP_MEMORY_SCOPE_AGENT) < target && ++spins < (1u << 24)) __builtin_amdgcn_s_sleep(2);
        __builtin_amdgcn_fence(__ATOMIC_ACQUIRE, "agent");
    }
    __syncthreads();
}
__global__ void __launch_bounds__(512, 2) mk_fwd(Args a) {
    extern __shared__ __attribute__((aligned(16))) unsigned char lds_raw[];
    LAS unsigned char* lds = (LAS unsigned char*)lds_raw;
    cg::grid_group grid = cg::this_grid();
    const Ctx C{a};
    const int lo = a.ph_lo, hi = a.ph_hi; unsigned nbar = 0;
#ifdef ONLY
#define IN(k) ((k) == ONLY && lo <= (k) && (k) < hi)
#else
#define IN(k) (lo <= (k) && (k) < hi)
#endif
#define SEAM(k) do { if (IN(k) && IN((k) + 1)) { if ((k) == 0) grid.sync(); else { ++nbar; grid_bar(C.ctl() + 64, nbar * gridDim.x); } } } while (0)
    if (IN(0)) phase0(C, lds);
    SEAM(0);
    if (IN(1)) { pg8::Gemm g{C.H(), C.WT1(), TP, 12288, D}; pg8::StaticOrder S; S.init(TP, 12288, (int)gridDim.x, (int)blockIdx.x);
        EpiStore Ep{C.P1(), N1P}; if (!(a.flags & 2)) pg8::gemm_phase<EpiStore, pg8::StaticOrder, true, true>(lds, g, S, Ep);
        const int t1 = fresh_tid(), lane = t1 & 63, wave = __builtin_amdgcn_readfirstlane(t1 >> 6), i16 = lane & 15, q4 = lane >> 4;
        if (!(a.flags & 1)) {
            bf16* P1 = C.P1();
            for (int job = blockIdx.x; job < TP / 32; job += gridDim.x) { const int r0 = job * 32 + (wave >> 2) * 16, c0 = OFF_B + (wave & 3) * 16;
                skinny_wg<4, 1, D, D>(C.H() + (size_t)r0 * D, D, C.WT1() + (size_t)OFF_B * D, lds, t1, wave & 3, job >> 3, [&](int j, const f32x4 v) {
                    *(v2u*)(P1 + (size_t)(r0 + i16) * N1P + c0 + 4 * q4) = pk4(v); }); }
            for (int job = blockIdx.x; job < N1 / 64; job += gridDim.x) { const int r0 = TP + wave * 16, c0 = job * 64;
                skinny_wg<4, 4, D, D>(C.H() + (size_t)r0 * D, D, C.WT1() + (size_t)c0 * D, lds, t1, 0, job >> 3, [&](int j, const f32x4 v) {
                    *(v2u*)(P1 + (size_t)(r0 + i16) * N1P + c0 + 16 * j + 4 * q4) = pk4(v); }); }
        } }
    SEAM(1);
    if (IN(2)) phase2(C, lds);
    SEAM(2);
    if (IN(3)) phase3(C, lds);
    SEAM(3);
    if (IN(4)) { pg8::Gemm g{C.OG(), C.WT2(), TP, D, E}; pg8::StaticOrder S; S.init(TP, D, (int)gridDim.x, (int)blockIdx.x);
        EpiResid Ep{C.xp(), C.xs(), C.X1()}; if (!(a.flags & 2)) pg8::gemm_phase<EpiResid, pg8::StaticOrder, true, true>(lds, g, S, Ep);
        const int t1 = fresh_tid(), lane = t1 & 63, wave = __builtin_amdgcn_readfirstlane(t1 >> 6), i16 = lane & 15, q4 = lane >> 4;
        if (!(a.flags & 1)) {   float* X1 = C.X1(); const float* xs = C.xs();
            for (int job = blockIdx.x; job < 2 * (D / 16); job += gridDim.x) { const int r0 = TP + wave * 16, c0 = (job >> 1) * 16, kh = (job & 1) * (E / 2);
                skinny_wg<1, 1, E / 2, E>(C.OG() + (size_t)r0 * E + kh, E, C.WT2() + (size_t)c0 * E + kh, lds, t1, 0, job >> 3, [&](int j, const f32x4 v) {
                    float* p = X1 + (size_t)(r0 + i16) * D + c0 + 4 * q4;
                    atomicAdd(p, v[0]); atomicAdd(p + 1, v[1]); atomicAdd(p + 2, v[2]); atomicAdd(p + 3, v[3]); }); } } }
    SEAM(4);
    if (IN(5)) { const int t5 = fresh_tid(), lane = t5 & 63, gw = blockIdx.x * 8 + (t5 >> 6), NGW = gridDim.x * 8; for (int m = gw; m < MV; m += NGW) rms_row_bf16(C.X1() + (size_t)m * D, C.nssm(), C.H() + (size_t)m * D, lane); }
    SEAM(5);
    if (IN(6)) { pg8::Gemm g{C.H(), C.WT3(), TP, NZ, D}; pg8::StaticOrder S; S.init(TP, NZ, (int)gridDim.x, (int)blockIdx.x);
        EpiStore Ep{C.UZ(), NZ}; if (!(a.flags & 2)) pg8::gemm_phase<EpiStore, pg8::StaticOrder, true, true>(lds, g, S, Ep);
        const int t1 = fresh_tid(), lane = t1 & 63, wave = __builtin_amdgcn_readfirstlane(t1 >> 6), i16 = lane & 15, q4 = lane >> 4;
        if (!(a.flags & 1)) {   bf16* UZ = C.UZ();
            for (int job = blockIdx.x; job < NZ / 32; job += gridDim.x) { const int r0 = TP + wave * 16, c0 = job * 32;
                skinny_wg<2, 2, D, D>(C.H() + (size_t)r0 * D, D, C.WT3() + (size_t)c0 * D, lds, t1, 0, job >> 3, [&](int j, const f32x4 v) {
                    *(v2u*)(UZ + (size_t)(r0 + i16) * NZ + c0 + 16 * j + 4 * q4) = pk4(v); }); } } }
    SEAM(6);
    if (IN(7)) phase7(C, lds);
    SEAM(7);
    if (IN(8)) { pg8::Gemm g{C.YG(), C.WT4(), TP, E, E}; pg8::StaticOrder S; S.init(TP, E, (int)gridDim.x, (int)blockIdx.x);
        EpiGlu Ep{C.YG(), C.UZ(), C.bglu(), C.Y2()}; if (!(a.flags & 2)) pg8::gemm_phase<EpiGlu, pg8::StaticOrder, true, true>(lds, g, S, Ep);
        const int t1 = fresh_tid(), lane = t1 & 63, wave = __builtin_amdgcn_readfirstlane(t1 >> 6), i16 = lane & 15, q4 = lane >> 4;
        if (!(a.flags & 1)) {   bf16* Y2 = C.Y2(); const bf16* YG = C.YG(); const bf16* UZ = C.UZ(); const float* bg = C.bglu();
            for (int job = blockIdx.x; job < E / 16; job += gridDim.x) { const int r0 = TP + wave * 16, c0 = job * 16;
                skinny_wg<1, 1, E, E>(YG + (size_t)r0 * E, E, C.WT4() + (size_t)c0 * E, lds, t1, 0, job >> 3, [&](int j, const f32x4 v) {
                    const size_t r = r0 + i16; const int c = c0 + 4 * q4;
                    const v2u yv = *(const v2u*)(YG + r * E + c), zv = *(const v2u*)(UZ + r * NZ + E + c); const f32x4 gt = v + *(const f32x4*)(bg + c);
                    f32x4 o; o[0] = lo_bf(yv.x) * sigmoidf_(gt[0]) * siluf_(lo_bf(zv.x)); o[1] = hi_bf(yv.x) * sigmoidf_(gt[1]) * siluf_(hi_bf(zv.x));
                    o[2] = lo_bf(yv.y) * sigmoidf_(gt[2]) * siluf_(lo_bf(zv.y)); o[3] = hi_bf(yv.y) * sigmoidf_(gt[3]) * siluf_(hi_bf(zv.y));
                    *(v2u*)(Y2 + r * E + c) = pk4(o); }); } } }
    SEAM(8);
    if (IN(9)) { pg8::Gemm g{C.Y2(), C.WT5(), TP, D, E}; pg8::StaticOrder S; S.init(TP, D, (int)gridDim.x, (int)blockIdx.x);
        EpiResid2 Ep{C.X1()}; if (!(a.flags & 2)) pg8::gemm_phase<EpiResid2, pg8::StaticOrder, true, true>(lds, g, S, Ep);
        const int t1 = fresh_tid(), lane = t1 & 63, wave = __builtin_amdgcn_readfirstlane(t1 >> 6), i16 = lane & 15, q4 = lane >> 4;
        if (!(a.flags & 1)) {   float* X1 = C.X1();
            for (int job = blockIdx.x; job < 2 * (D / 16); job += gridDim.x) { const int r0 = TP + wave * 16, c0 = (job >> 1) * 16, kh = (job & 1) * (E / 2);
                skinny_wg<1, 1, E / 2, E>(C.Y2() + (size_t)r0 * E + kh, E, C.WT5() + (size_t)c0 * E + kh, lds, t1, 0, job >> 3, [&](int j, const f32x4 v) {
                    float* p = X1 + (size_t)(r0 + i16) * D + c0 + 4 * q4;
                    atomicAdd(p, v[0]); atomicAdd(p + 1, v[1]); atomicAdd(p + 2, v[2]); atomicAdd(p + 3, v[3]); }); } } }
    SEAM(9);
    if (IN(10)) { const int t10 = fresh_tid(), lane = t10 & 63, gw = blockIdx.x * 8 + (t10 >> 6), NGW = gridDim.x * 8; for (int m = gw; m < MV; m += NGW) rms_row_f32(C.X1() + (size_t)m * D, C.nfin(), m < TP ? C.out() + O_YP + (size_t)m * D : C.out() + O_YS + (size_t)(m - TP) * D, lane); }
}

#ifndef MK_SPLIT
#define MK_SPLIT 0
#endif
extern "C" void kernel_launch(void* const* d_in, const int* in_sizes, int n_in, void* d_out, int out_size, void* d_ws, size_t ws_size, hipStream_t stream) {
    static int grid = 0;
    if (grid == 0) {
        if (n_in != 27 || (size_t)out_size != O_END || ws_size < WS_END) { fprintf(stderr, "kernel_launch: unexpected problem (n_in %d, out %d, ws %zu)\n", n_in, out_size, ws_size); grid = -1; return; }
        int dev = 0, cus = 0, per_cu = 0;
        if (hipGetDevice(&dev) != hipSuccess || hipDeviceGetAttribute(&cus, hipDeviceAttributeMultiprocessorCount, dev) != hipSuccess) { grid = -1; return; }
        if (hipFuncSetAttribute((const void*)mk_fwd, hipFuncAttributeMaxDynamicSharedMemorySize, LDS_BYTES) != hipSuccess) { fprintf(stderr, "kernel_launch: hipFuncSetAttribute failed\n"); grid = -1; return; }
        if (hipOccupancyMaxActiveBlocksPerMultiprocessor(&per_cu, (const void*)mk_fwd, 512, LDS_BYTES) != hipSuccess || per_cu < 1) { fprintf(stderr, "kernel_launch: occupancy query says %d\n", per_cu); (void)hipGetLastError(); grid = -1; return; }
        grid = cus;
    }
    if (grid < 0) return;
    (void)hipMemsetAsync((char*)d_ws + WS_CTL, 0, 4096, stream);
    Args a{};
    for (int i = 0; i < 27; ++i) a.in[i] = (const float*)d_in[i];
    a.out = (float*)d_out; a.ws = (unsigned char*)d_ws;
#if MK_SPLIT
    for (int p = 0; p <= 10; ++p) { a.ph_lo = p; a.ph_hi = p + 1; hipLaunchKernelGGL(mk_fwd, dim3(grid), dim3(512), LDS_BYTES, stream, a); }
#else
    a.ph_lo = 0; a.ph_hi = 11;
    void* args[] = {&a};
    hipError_t e = hipLaunchCooperativeKernel((const void*)mk_fwd, dim3(grid), dim3(512), args, LDS_BYTES, stream);
    if (e != hipSuccess) fprintf(stderr, "kernel_launch: cooperative launch failed: %s (grid %d)\n", hipGetErrorString(e), grid);
#endif
#ifdef PROBE_EXTRA
    for (int p = 0; p <= 11; ++p) if ((PROBE_EXTRA >> p) & 1) {
        if (p == 3) (void)hipMemsetAsync((char*)d_ws + WS_CTL, 0, 4096, stream);
        a.ph_lo = p; a.ph_hi = p + 1; a.out = (float*)((char*)d_ws + 64 * MiB);
#ifdef PROBE_FLAGS
        a.flags = PROBE_FLAGS;
#endif
        hipLaunchKernelGGL(mk_fwd, dim3(grid), dim3(512), LDS_BYTES, stream, a); }
#endif
}
```

```cpp
#include <hip/hip_runtime.h>
#include <hip/hip_cooperative_groups.h>
#include <cstdio>
#include <cstdint>
namespace cg = cooperative_groups;
namespace pg8 {
#define PG8_LAS __attribute__((address_space(3)))
typedef unsigned short bf16_t;
typedef short bf16x8 __attribute__((ext_vector_type(8)));
typedef float f32x4 __attribute__((ext_vector_type(4)));
typedef unsigned u32x4 __attribute__((ext_vector_type(4)));
constexpr int BM = 256, BK = 64, HALF = 128, HTB = HALF * BK * 2  , STAGE_BYTES = 8 * HTB, NXCD = 8, WGM = 3;

__host__ __device__ __forceinline__ int lds_byte(int r, int c) { const int st = (r >> 4) * 2 + (c >> 5), rr = r & 15, cc = c & 31, ob = rr * 64 + cc * 2; return st * 1024 + (ob ^ (((ob >> 9) & 1) << 5)); }
__host__ __device__ __forceinline__ void stage_rc(int b, int& R, int& C) { const int st = b / 1024, sb = b % 1024, swz = sb ^ (((sb >> 9) & 1) << 5); R = (st >> 1) * 16 + swz / 64; C = (st & 1) * 32 + (swz % 64) / 2; }
__host__ __device__ __forceinline__ int perm32(int rho) { const int n = rho >> 4, i = rho & 15; return 8 * (i >> 2) + 4 * n + (i & 3); }

struct Unit { int pm, pn; };
struct Gemm { const bf16_t* A; const bf16_t* Bt; int M, N, K; };

struct StaticOrder {
    int nM, nN, nwg, G, c;
    __host__ __device__ void init(int M, int N, int G_, int c_) { nM = M / BM; nN = N / BM; nwg = nM * nN; G = G_; c = c_; }
    __host__ __device__ bool next(int i, Unit& u) const {
        const long L = (long)i * G + c; if (L >= nwg) return false;
        int wgid = (int)L; { const int q = nwg / NXCD, r = nwg % NXCD, xcd = wgid % NXCD, off = wgid / NXCD; wgid = (xcd < r ? xcd * (q + 1) : r * (q + 1) + (xcd - r) * q) + off; }
        const int nig = WGM * nN, gid = wgid / nig, fm = gid * WGM, gsz = (nM - fm) < WGM ? (nM - fm) : WGM;
        u.pm = fm + ((wgid % nig) % gsz); u.pn = (wgid % nig) / gsz; return true;
    }
    __device__ __forceinline__ void a_ready(const Unit&) const {}
    __device__ __forceinline__ void done(const Unit&) const {}
};

__device__ __forceinline__ unsigned cvt_pk_bf16(float lo, float hi) { unsigned r; asm volatile("v_cvt_pk_bf16_f32 %0, %1, %2" : "=v"(r) : "v"(lo), "v"(hi)); return r; }

template <class Epi, class Sched, bool ALIGN_EPI = false, bool SP2 = false>
__device__ __forceinline__ void gemm_phase(PG8_LAS unsigned char* lds, const Gemm g, const Sched& S, const Epi& E) {
    const int tid = threadIdx.x, wid = __builtin_amdgcn_readfirstlane(tid >> 6), lane = tid & 63, wr = wid >> 2, wc = wid & 3, fr = lane & 15, fq = lane >> 4;
    const int K = g.K, nt = K / BK;
    unsigned voffA[2], voffB[2];
#pragma unroll
    for (int i = 0; i < 2; ++i) { int R, C; stage_rc(tid * 16 + i * 8192, R, C); const int Rb = Epi::PERM ? ((R & ~31) + perm32(R & 31)) : R;
        voffA[i] = (unsigned)(R * K + C) * 2u; voffB[i] = (unsigned)(Rb * K + C) * 2u; }
    const size_t kstep = (size_t)(BK * 2);
    const size_t hstep = (size_t)HALF * K * 2;
    const size_t tstep = 2 * hstep;
    const unsigned ldsw = (unsigned)wid * 1024u;
    const int aoff = lds_byte(wr * 64 + fr, fq * 8), boff = lds_byte(wc * 32 + fr, fq * 8);
#define PG8_SA(b, h) (((b) * 2 + (h)) * HTB)
#define PG8_SB(b, h) ((4 + (b) * 2 + (h)) * HTB)
#define PG8_STAGE(bufoff, gbase, voff) do { _Pragma("unroll") for (int _i = 0; _i < 2; ++_i) \
        __builtin_amdgcn_global_load_lds((const unsigned*)((const char*)(gbase) + (voff)[_i]), (PG8_LAS unsigned*)(lds + (bufoff) + ldsw + _i * 8192), 16, 0, 0); } while (0)
#define PG8_LDA(dst, b, h) do { _Pragma("unroll") for (int m = 0; m < 4; ++m) _Pragma("unroll") for (int k = 0; k < 2; ++k) dst[m][k] = *(const PG8_LAS bf16x8*)(lds + PG8_SA(b, h) + aoff + m * 2048 + k * 1024); } while (0)
#define PG8_LDB(dst, b, h) do { _Pragma("unroll") for (int n = 0; n < 2; ++n) _Pragma("unroll") for (int k = 0; k < 2; ++k) dst[n][k] = *(const PG8_LAS bf16x8*)(lds + PG8_SB(b, h) + boff + n * 2048 + k * 1024); } while (0)
#define PG8_MMA(ai, bj, At, Bt) do { __builtin_amdgcn_s_setprio(1); _Pragma("unroll") for (int m = 0; m < 4; ++m) _Pragma("unroll") for (int n = 0; n < 2; ++n) _Pragma("unroll") for (int k = 0; k < 2; ++k) \
        acc[ai][bj][m][n] = __builtin_amdgcn_mfma_f32_16x16x32_bf16(Bt[n][k], At[m][k], acc[ai][bj][m][n], 0, 0, 0); __builtin_amdgcn_s_setprio(0); } while (0)
#define PG8_WAIT_V(n) asm volatile("s_waitcnt vmcnt(" #n ")" ::: "memory")
#define PG8_WAIT_L(n) asm volatile("s_waitcnt lgkmcnt(" #n ")" ::: "memory")
#define PG8_BAR __builtin_amdgcn_s_barrier()
#define PG8_SCHED __builtin_amdgcn_sched_barrier(0)
    Unit cur, nxt; int ui = 0;
    if (!S.next(0, cur)) return;
    f32x4 acc[2][2][4][2];
#pragma unroll
    for (int a = 0; a < 2; ++a)
#pragma unroll
        for (int b = 0; b < 2; ++b)
#pragma unroll
            for (int m = 0; m < 4; ++m)
#pragma unroll
                for (int n = 0; n < 2; ++n) acc[a][b][m][n] = (f32x4){0.f, 0.f, 0.f, 0.f};
    bf16x8 At[4][2], B0[2][2], B1[2][2];
    const char* cA = (const char*)g.A + (size_t)cur.pm * tstep; const char* cB = (const char*)g.Bt + (size_t)cur.pn * tstep;
    S.a_ready(cur);
    if constexpr (SP2) {
        PG8_STAGE(PG8_SB(0, 0), cB, voffB); PG8_STAGE(PG8_SB(0, 1), cB + hstep, voffB); PG8_STAGE(PG8_SA(0, 0), cA, voffA); PG8_STAGE(PG8_SA(0, 1), cA + hstep, voffA);
        if (wr == 1) PG8_BAR;
        PG8_WAIT_V(2); PG8_BAR;
        PG8_STAGE(PG8_SB(1, 0), cB + kstep, voffB); PG8_STAGE(PG8_SA(1, 0), cA + kstep, voffA); PG8_STAGE(PG8_SB(1, 1), cB + hstep + kstep, voffB);
        PG8_WAIT_V(6); PG8_BAR;
    } else {
        PG8_STAGE(PG8_SB(0, 0), cB, voffB); PG8_STAGE(PG8_SA(0, 0), cA, voffA); PG8_STAGE(PG8_SB(0, 1), cB + hstep, voffB); PG8_STAGE(PG8_SA(0, 1), cA + hstep, voffA);
        if (wr == 1) PG8_BAR;
        PG8_WAIT_V(4); PG8_BAR;
        PG8_STAGE(PG8_SB(1, 0), cB + kstep, voffB); PG8_STAGE(PG8_SA(1, 0), cA + kstep, voffA); PG8_STAGE(PG8_SB(1, 1), cB + hstep + kstep, voffB);
        PG8_WAIT_V(6); PG8_BAR;
    }
    for (;;) {
        const bool has_next = S.next(ui + 1, nxt);
        const char* nA = has_next ? (const char*)g.A + (size_t)nxt.pm * tstep : cA; const char* nB = has_next ? (const char*)g.Bt + (size_t)nxt.pn * tstep : cB;
        for (int t = 0; t < nt; t += 2) {
            const bool last = (t == nt - 2);
            const char* a1 = cA + (size_t)(t + 1) * kstep;
            const char* a2 = last ? nA : cA + (size_t)(t + 2) * kstep; const char* b2 = last ? nB : cB + (size_t)(t + 2) * kstep;
            const char* a3 = a2 + kstep; const char* b3 = b2 + kstep;
            if (last && has_next) S.a_ready(nxt);
            if constexpr (SP2) {
            PG8_LDB(B0, 0, 0); PG8_LDB(B1, 0, 1); PG8_SCHED; PG8_LDA(At, 0, 0); PG8_STAGE(PG8_SA(1, 1), a1 + hstep, voffA);
            PG8_WAIT_V(8); PG8_WAIT_L(0); PG8_BAR; PG8_MMA(0, 0, At, B0); PG8_MMA(0, 1, At, B1); PG8_BAR; PG8_SCHED;
            PG8_LDA(At, 0, 1); PG8_STAGE(PG8_SB(0, 0), b2, voffB); PG8_STAGE(PG8_SB(0, 1), b2 + hstep, voffB); PG8_STAGE(PG8_SA(0, 0), a2, voffA);
            PG8_WAIT_V(8); PG8_WAIT_L(0); PG8_BAR; PG8_MMA(1, 0, At, B0); PG8_MMA(1, 1, At, B1); PG8_BAR; PG8_SCHED;
            PG8_LDB(B0, 1, 0); PG8_LDB(B1, 1, 1); PG8_SCHED; PG8_LDA(At, 1, 0); PG8_STAGE(PG8_SA(0, 1), a2 + hstep, voffA);
            PG8_WAIT_V(8); PG8_WAIT_L(0); PG8_BAR; PG8_MMA(0, 0, At, B0); PG8_MMA(0, 1, At, B1); PG8_BAR; PG8_SCHED;
            PG8_LDA(At, 1, 1); PG8_STAGE(PG8_SB(1, 0), b3, voffB); PG8_STAGE(PG8_SB(1, 1), b3 + hstep, voffB); PG8_STAGE(PG8_SA(1, 0), a3, voffA);
            PG8_WAIT_V(8); PG8_WAIT_L(0); PG8_BAR; PG8_MMA(1, 0, At, B0); PG8_MMA(1, 1, At, B1); PG8_BAR; PG8_SCHED;
            } else {
            PG8_LDB(B0, 0, 0); PG8_SCHED; PG8_LDA(At, 0, 0); PG8_STAGE(PG8_SA(1, 1), a1 + hstep, voffA);
            PG8_WAIT_L(8); PG8_BAR; PG8_WAIT_L(0); PG8_MMA(0, 0, At, B0); PG8_BAR; PG8_SCHED;
            PG8_LDB(B1, 0, 1); PG8_STAGE(PG8_SB(0, 0), b2, voffB);
            PG8_BAR; PG8_WAIT_L(0); PG8_MMA(0, 1, At, B1); PG8_BAR;
            PG8_LDA(At, 0, 1); PG8_STAGE(PG8_SA(0, 0), a2, voffA);
            PG8_BAR; PG8_WAIT_L(0); PG8_MMA(1, 0, At, B0); PG8_BAR; PG8_SCHED;
            PG8_STAGE(PG8_SB(0, 1), b2 + hstep, voffB);
            PG8_WAIT_V(6); PG8_BAR; PG8_MMA(1, 1, At, B1); PG8_BAR;
            PG8_LDB(B0, 1, 0); PG8_SCHED; PG8_LDA(At, 1, 0); PG8_STAGE(PG8_SA(0, 1), a2 + hstep, voffA);
            PG8_WAIT_L(8); PG8_BAR; PG8_WAIT_L(0); PG8_MMA(0, 0, At, B0); PG8_BAR; PG8_SCHED;
            PG8_LDB(B1, 1, 1); PG8_STAGE(PG8_SB(1, 0), b3, voffB);
            PG8_BAR; PG8_WAIT_L(0); PG8_MMA(0, 1, At, B1); PG8_BAR;
            PG8_LDA(At, 1, 1); PG8_STAGE(PG8_SA(1, 0), a3, voffA);
            PG8_BAR; PG8_WAIT_L(0); PG8_MMA(1, 0, At, B0); PG8_BAR; PG8_SCHED;
            PG8_STAGE(PG8_SB(1, 1), b3 + hstep, voffB);
            PG8_WAIT_V(6); PG8_BAR; PG8_MMA(1, 1, At, B1); PG8_BAR;
            }
        }
        if constexpr (ALIGN_EPI) { if (wr == 0) PG8_BAR; }
        if constexpr (!Epi::AFTER_DRAIN) { E(acc, cur, wr, wc, fr, fq); S.done(cur); }
        if (!has_next) break;
#pragma unroll
        for (int a = 0; a < 2; ++a)
#pragma unroll
            for (int b = 0; b < 2; ++b)
#pragma unroll
                for (int m = 0; m < 4; ++m)
#pragma unroll
                    for (int n = 0; n < 2; ++n) acc[a][b][m][n] = (f32x4){0.f, 0.f, 0.f, 0.f};
        cur = nxt; cA = nA; cB = nB; ++ui;
        if constexpr (ALIGN_EPI) { if (wr == 1) PG8_BAR; }
    }
    PG8_WAIT_V(0);
    if constexpr (!ALIGN_EPI) { if (wr == 0) PG8_BAR; }
    PG8_BAR;
    if constexpr (Epi::AFTER_DRAIN) { E.fused(acc, cur, wr, wc, fr, fq, lds, wid, lane); S.done(cur); }
#undef PG8_SA
#undef PG8_SB
#undef PG8_STAGE
#undef PG8_LDA
#undef PG8_LDB
#undef PG8_MMA
#undef PG8_WAIT_V
#undef PG8_WAIT_L
#undef PG8_BAR
#undef PG8_SCHED
}
}

#define LAS __attribute__((address_space(3)))
typedef unsigned short bf16;
typedef unsigned v4u __attribute__((ext_vector_type(4)));
typedef unsigned v2u __attribute__((ext_vector_type(2)));
typedef float f32x4 __attribute__((ext_vector_type(4)));
typedef float f32x16 __attribute__((ext_vector_type(16)));
typedef short bf16x8 __attribute__((ext_vector_type(8)));
typedef __bf16 bf16x2_t __attribute__((ext_vector_type(2)));
typedef float f32x2_t __attribute__((ext_vector_type(2)));

constexpr int D = 2048, TP = 8192, NSMP = 128, MV = TP + NSMP, MP = 8448;
constexpr int SEQ = 2048, NB = 4;
constexpr int N1 = 12352, N1P = 12544;
constexpr int E = 4096;
constexpr int NZ = 8192;
constexpr int OFF_B = 12288, OFF_A = 12320;
constexpr int LDS_BYTES = 147456;
constexpr float RMS_EPS = 1e-6f;

constexpr size_t MiB = 1u << 20;
constexpr size_t WS_CTL = 0;
constexpr size_t WS_WT1 = 1 * MiB, WS_WT2 = 50 * MiB, WS_WT3 = 66 * MiB, WS_WT4 = 98 * MiB, WS_WT5 = 130 * MiB;
constexpr size_t WS_AR = 146 * MiB, WS_AI = WS_AR + 65536, WS_GL = WS_AI + 65536, WS_BBT = 147 * MiB, WS_CMT = 148 * MiB;
constexpr size_t WS_H = 149 * MiB;
constexpr size_t WS_P1 = 182 * MiB;
constexpr size_t WS_UZ = WS_P1;
constexpr size_t WS_REC = 385 * MiB;
constexpr size_t WS_YG = WS_REC, WS_Y2 = WS_REC + 66 * MiB;
constexpr size_t WS_OG = 673 * MiB;
constexpr size_t WS_X1 = 739 * MiB;
constexpr size_t WS_END = 805 * MiB;
constexpr int REC_BYTES = 73728, REC_WN = 0, REC_QD = 16384, REC_AT = 32768, REC_KDT = 40960, REC_UT = 57344;

constexpr size_t O_YP = 0, O_YS = 16777216, O_CONVP = O_YS + 262144, O_DELTAP = O_CONVP + 98304, O_REP = O_DELTAP + 2097152, O_IMP = O_REP + 65536,
                 O_CONVS = O_IMP + 65536, O_DELTAS = O_CONVS + 3145728, O_RES = O_DELTAS + 67108864, O_IMS = O_RES + 2097152, O_END = O_IMS + 2097152;

__device__ __forceinline__ float bf2f(unsigned short u) { return __uint_as_float((unsigned)u << 16); }
__device__ __forceinline__ unsigned pk2(float lo, float hi) { f32x2_t v = {lo, hi}; bf16x2_t b = __builtin_convertvector(v, bf16x2_t); return __builtin_bit_cast(unsigned, b); }
__device__ __forceinline__ unsigned short f2bf(float f) { return (unsigned short)(pk2(f, 0.f) & 0xffffu); }
__device__ __forceinline__ float lo_bf(unsigned u) { return __uint_as_float(u << 16); }
__device__ __forceinline__ float hi_bf(unsigned u) { return __uint_as_float(u & 0xffff0000u); }
__device__ __forceinline__ float wave_sum(float v) {
#pragma unroll
    for (int o = 1; o < 64; o <<= 1) v += __shfl_xor(v, o);
    return v;
}
__device__ __forceinline__ float sigmoidf_(float x) { return __builtin_amdgcn_rcpf(1.f + __expf(-x)); }
__device__ __forceinline__ float siluf_(float x) { return x * __builtin_amdgcn_rcpf(1.f + __expf(-x)); }
__device__ __forceinline__ float gelu_tanh(float x) {
    const float u = 0.7978845608028654f * (x + 0.044715f * x * x * x);
    const float t = 1.f - 2.f * __builtin_amdgcn_rcpf(1.f + __expf(2.f * u));
    return 0.5f * x * (1.f + t);
}
#define LDS_WAIT() asm volatile("s_waitcnt lgkmcnt(0)" ::: "memory")
#define MFMA32(a, b, c) __builtin_amdgcn_mfma_f32_32x32x16_bf16((a), (b), (c), 0, 0, 0)
#define BAR_LDS() do { asm volatile("s_waitcnt lgkmcnt(0)" ::: "memory"); __builtin_amdgcn_s_barrier(); asm volatile("" ::: "memory"); } while (0)
__device__ __forceinline__ int fresh_tid() { int t = threadIdx.x; asm volatile("" : "+v"(t)); return t; }

struct Args { const float* in[27]; float* out; unsigned char* ws; int ph_lo, ph_hi, flags, pad; };
struct Ctx {
    const Args& a;
#define CIN(name, k) __device__ __forceinline__ const float* name() const { return a.in[k]; }
    CIN(xp, 0) CIN(xs, 1) CIN(cs, 2) CIN(ds, 3) CIN(sre, 4) CIN(sim, 5) CIN(ng, 6) CIN(wing, 7) CIN(convw, 8) CIN(alog, 9) CIN(dtb, 10) CIN(onorm, 11) CIN(woutg, 12) CIN(nssm, 13)
    CIN(wins, 14) CIN(lre, 15) CIN(lim, 16) CIN(bre, 17) CIN(bim, 18) CIN(cre, 19) CIN(cim, 20) CIN(dssm, 21) CIN(logdt, 22) CIN(wglu, 23) CIN(bglu, 24) CIN(wouts, 25) CIN(nfin, 26)
#undef CIN
    __device__ __forceinline__ float* out() const { return a.out; }
#define CWS(type, name, off) __device__ __forceinline__ type* name() const { return (type*)(a.ws + (off)); }
    CWS(bf16, WT1, WS_WT1) CWS(bf16, WT2, WS_WT2) CWS(bf16, WT3, WS_WT3) CWS(bf16, WT4, WS_WT4) CWS(bf16, WT5, WS_WT5) CWS(bf16, H, WS_H) CWS(bf16, P1, WS_P1) CWS(bf16, OG, WS_OG)
    CWS(bf16, UZ, WS_UZ) CWS(bf16, YG, WS_YG) CWS(bf16, Y2, WS_Y2) CWS(bf16, BBT, WS_BBT) CWS(bf16, CMT, WS_CMT) CWS(float, X1, WS_X1) CWS(float, AR, WS_AR) CWS(float, AI, WS_AI)
    CWS(float, GL, WS_GL) CWS(unsigned char, REC, WS_REC) CWS(unsigned, ctl, WS_CTL)
#undef CWS
};

struct EpiStore {
    static constexpr bool PERM = true, AFTER_DRAIN = false;
    bf16* O; int ldc;
    __device__ __forceinline__ void operator()(const pg8::f32x4 (&acc)[2][2][4][2], const pg8::Unit& u, int wr, int wc, int fr, int fq) const {
        const int row0 = u.pm * 256 + wr * 64 + fr, col0 = u.pn * 256 + wc * 32 + 8 * fq;
#pragma unroll
        for (int ai = 0; ai < 2; ++ai)
#pragma unroll
            for (int m = 0; m < 4; ++m) { bf16* rowp = O + (size_t)(row0 + ai * 128 + m * 16) * ldc + col0;
#pragma unroll
                for (int bj = 0; bj < 2; ++bj) { const pg8::f32x4 v0 = acc[ai][bj][m][0], v1 = acc[ai][bj][m][1];
                    v4u w; w.x = pk2(v0[0], v0[1]); w.y = pk2(v0[2], v0[3]); w.z = pk2(v1[0], v1[1]); w.w = pk2(v1[2], v1[3]);
                    *(v4u*)(rowp + bj * 128) = w; } }
    }
};
struct EpiResid {
    static constexpr bool PERM = true, AFTER_DRAIN = false;
    const float* xp; const float* xs; float* X1;
    __device__ __forceinline__ void operator()(const pg8::f32x4 (&acc)[2][2][4][2], const pg8::Unit& u, int wr, int wc, int fr, int fq) const {
        const int row0 = u.pm * 256 + wr * 64 + fr, col0 = u.pn * 256 + wc * 32 + 8 * fq;
#pragma unroll
        for (int ai = 0; ai < 2; ++ai)
#pragma unroll
            for (int m = 0; m < 4; ++m) { const int r = row0 + ai * 128 + m * 16;
                if (r < MV) { const float* xr = (r < TP ? xp + (size_t)r * D : xs + (size_t)(r - TP) * D) + col0; float* orow = X1 + (size_t)r * D + col0;
#pragma unroll
                    for (int bj = 0; bj < 2; ++bj) { const f32x4 a0 = __builtin_nontemporal_load((const f32x4*)(xr + bj * 128)), a1 = __builtin_nontemporal_load((const f32x4*)(xr + bj * 128 + 4));
                        *(f32x4*)(orow + bj * 128) = a0 + acc[ai][bj][m][0]; *(f32x4*)(orow + bj * 128 + 4) = a1 + acc[ai][bj][m][1]; } } }
    }
};
struct EpiResid2 {
    static constexpr bool PERM = true, AFTER_DRAIN = false;
    float* X1;
    __device__ __forceinline__ void operator()(const pg8::f32x4 (&acc)[2][2][4][2], const pg8::Unit& u, int wr, int wc, int fr, int fq) const {
        const int row0 = u.pm * 256 + wr * 64 + fr, col0 = u.pn * 256 + wc * 32 + 8 * fq;
#pragma unroll
        for (int ai = 0; ai < 2; ++ai)
#pragma unroll
            for (int m = 0; m < 4; ++m) { const int r = row0 + ai * 128 + m * 16;
                if (r < MV) { float* orow = X1 + (size_t)r * D + col0;
#pragma unroll
                    for (int bj = 0; bj < 2; ++bj) { const f32x4 a0 = *(const f32x4*)(orow + bj * 128), a1 = *(const f32x4*)(orow + bj * 128 + 4);
                        *(f32x4*)(orow + bj * 128) = a0 + acc[ai][bj][m][0]; *(f32x4*)(orow + bj * 128 + 4) = a1 + acc[ai][bj][m][1]; } } }
    }
};
struct EpiGlu {
    static constexpr bool PERM = true, AFTER_DRAIN = false;
    const bf16* YG; const bf16* UZ; const float* bglu; bf16* Y2;
    __device__ __forceinline__ void operator()(const pg8::f32x4 (&acc)[2][2][4][2], const pg8::Unit& u, int wr, int wc, int fr, int fq) const {
        const int row0 = u.pm * 256 + wr * 64 + fr, col0 = u.pn * 256 + wc * 32 + 8 * fq;
#pragma unroll
        for (int bj = 0; bj < 2; ++bj) { const int c = col0 + bj * 128; const f32x4 b0 = *(const f32x4*)(bglu + c), b1 = *(const f32x4*)(bglu + c + 4);
#pragma unroll
            for (int ai = 0; ai < 2; ++ai)
#pragma unroll
                for (int m = 0; m < 4; ++m) { const size_t r = (size_t)(row0 + ai * 128 + m * 16);
                    const v4u yv = *(const v4u*)(YG + r * E + c), zv = __builtin_nontemporal_load((const v4u*)(UZ + r * NZ + E + c));
                    const f32x4 g0 = acc[ai][bj][m][0] + b0, g1 = acc[ai][bj][m][1] + b1;
                    float o[8];
                    o[0] = lo_bf(yv.x) * sigmoidf_(g0[0]) * siluf_(lo_bf(zv.x)); o[1] = hi_bf(yv.x) * sigmoidf_(g0[1]) * siluf_(hi_bf(zv.x));
                    o[2] = lo_bf(yv.y) * sigmoidf_(g0[2]) * siluf_(lo_bf(zv.y)); o[3] = hi_bf(yv.y) * sigmoidf_(g0[3]) * siluf_(hi_bf(zv.y));
                    o[4] = lo_bf(yv.z) * sigmoidf_(g1[0]) * siluf_(lo_bf(zv.z)); o[5] = hi_bf(yv.z) * sigmoidf_(g1[1]) * siluf_(hi_bf(zv.z));
                    o[6] = lo_bf(yv.w) * sigmoidf_(g1[2]) * siluf_(lo_bf(zv.w)); o[7] = hi_bf(yv.w) * sigmoidf_(g1[3]) * siluf_(hi_bf(zv.w));
                    v4u w; w.x = pk2(o[0], o[1]); w.y = pk2(o[2], o[3]); w.z = pk2(o[4], o[5]); w.w = pk2(o[6], o[7]);
                    *(v4u*)(Y2 + r * E + c) = w; } }
    }
};

template <bool NTS = false>
__device__ __forceinline__ void p0_transpose_item(const float* W, int K, int N, bf16* WT, LAS float* scr, int item, int lane) {
    const int nblk = N / 32, kb = item / nblk, nb = item % nblk, k0 = 64 * kb, n0 = 32 * nb;
#pragma unroll 8
    for (int i = 0; i < 32; ++i) { const int kk = 2 * i + (lane >> 5); scr[kk * 33 + (lane & 31)] = __builtin_nontemporal_load(W + (size_t)(k0 + kk) * N + n0 + (lane & 31)); }
    LDS_WAIT(); asm volatile("" ::: "memory");
    const int c = lane & 7;
#pragma unroll
    for (int j = 0; j < 4; ++j) { const int n = (lane >> 3) + 8 * j; const LAS float* s = scr + (8 * c) * 33 + n;
        v4u o; o.x = pk2(s[0 * 33], s[1 * 33]); o.y = pk2(s[2 * 33], s[3 * 33]); o.z = pk2(s[4 * 33], s[5 * 33]); o.w = pk2(s[6 * 33], s[7 * 33]);
        if (NTS) __builtin_nontemporal_store(o, (v4u*)(WT + (size_t)(n0 + n) * K + k0 + 8 * c)); else *(v4u*)(WT + (size_t)(n0 + n) * K + k0 + 8 * c) = o; }
    LDS_WAIT(); asm volatile("" ::: "memory");
}
template <bool NT = false>
__device__ __forceinline__ void rms_row_bf16(const float* xrow, const float* g, bf16* orow, int lane) {
    const f32x4* xr = (const f32x4*)xrow + lane; f32x4 v[8]; float s = 0.f;
#pragma unroll
    for (int j = 0; j < 8; ++j) { v[j] = NT ? __builtin_nontemporal_load(xr + 64 * j) : xr[64 * j]; s += (v[j].x * v[j].x + v[j].y * v[j].y) + (v[j].z * v[j].z + v[j].w * v[j].w); }
    const float rs = 1.f / sqrtf(wave_sum(s) * (1.f / D) + RMS_EPS);
    const f32x4* gr = (const f32x4*)g + lane; v2u* o8 = (v2u*)orow + lane;
#pragma unroll
    for (int j = 0; j < 8; ++j) { const f32x4 gv = gr[64 * j]; v2u o; o.x = pk2(v[j].x * rs * gv.x, v[j].y * rs * gv.y); o.y = pk2(v[j].z * rs * gv.z, v[j].w * rs * gv.w); o8[64 * j] = o; }
}
__device__ __forceinline__ void rms_row_f32(const float* xrow, const float* g, float* orow, int lane) {
    const f32x4* xr = (const f32x4*)xrow + lane; f32x4 v[8]; float s = 0.f;
#pragma unroll
    for (int j = 0; j < 8; ++j) { v[j] = __builtin_nontemporal_load(xr + 64 * j); s += (v[j].x * v[j].x + v[j].y * v[j].y) + (v[j].z * v[j].z + v[j].w * v[j].w); }
    const float rs = 1.f / sqrtf(wave_sum(s) * (1.f / D) + RMS_EPS);
    const f32x4* gr = (const f32x4*)g + lane; f32x4* o = (f32x4*)orow + lane;
#pragma unroll
    for (int j = 0; j < 8; ++j) { const f32x4 gv = gr[64 * j]; __builtin_nontemporal_store(v[j] * rs * gv, o + 64 * j); }
}
__device__ __forceinline__ void phase0(const Ctx& C, LAS unsigned char* lds) {
    const int tid = fresh_tid(), lane = tid & 63, wave = tid >> 6;
    const int gw = blockIdx.x * 8 + wave, NGW = gridDim.x * 8;
    LAS float* scr = (LAS float*)(lds + wave * 16384);
    constexpr int I1 = (D / 64) * (N1 / 32), I2 = (E / 64) * (D / 32), I3 = (D / 64) * (NZ / 32), I4 = (E / 64) * (E / 32), I5 = I2, NIT = I1 + I2 + I3 + I4 + I5;
    for (int it = gw; it < NIT; it += NGW) {
        int r = it;
        if (r < I1) { p0_transpose_item(C.wing(), D, N1, C.WT1(), scr, r, lane); continue; } r -= I1;
        if (r < I2) { p0_transpose_item<true>(C.woutg(), E, D, C.WT2(), scr, r, lane); continue; } r -= I2;
        if (r < I3) { p0_transpose_item<true>(C.wins(), D, NZ, C.WT3(), scr, r, lane); continue; } r -= I3;
        if (r < I4) { p0_transpose_item<true>(C.wglu(), E, E, C.WT4(), scr, r, lane); continue; } r -= I4;
        p0_transpose_item<true>(C.wouts(), E, D, C.WT5(), scr, r, lane);
    }
    const int gt = blockIdx.x * 512 + tid, NGT = gridDim.x * 512;
    {
        v4u* z = (v4u*)(C.WT1() + (size_t)N1 * D); const v4u zero = {0u, 0u, 0u, 0u};
        for (int i = gt; i < (N1P - N1) * D / 8; i += NGT) z[i] = zero;
    }
    for (int m = gw; m < MP; m += NGW) {
        if (m < MV) rms_row_bf16<true>(m < TP ? C.xp() + (size_t)m * D : C.xs() + (size_t)(m - TP) * D, C.ng(), C.H() + (size_t)m * D, lane);
        else { v4u* o = (v4u*)(C.H() + (size_t)m * D); const v4u zero = {0u, 0u, 0u, 0u};
#pragma unroll
            for (int j = 0; j < 4; ++j) o[lane + 64 * j] = zero; }
    }
    if (gt < 256 * 64) {
        const int g = gt >> 6, p = gt & 63;
        const float lr = fminf(C.lre()[gt], -1e-4f), li = C.lim()[gt], dt = expf(C.logdt()[g]);
        const float mag = expf(lr * dt), ar = mag * cosf(li * dt), ai = mag * sinf(li * dt);
        const float den = lr * lr + li * li, xr = ar - 1.f, fr = (xr * lr + ai * li) / den, fi = (ai * lr - xr * li) / den;
        C.AR()[gt] = ar; C.AI()[gt] = ai;
        const float* br = C.bre() + (size_t)gt * 16; const float* bi = C.bim() + (size_t)gt * 16;
        bf16* o_re = C.BBT() + ((size_t)g * 128 + p) * 16; bf16* o_im = C.BBT() + ((size_t)g * 128 + 64 + p) * 16;
#pragma unroll
        for (int c = 0; c < 16; ++c) { const float b_r = br[c], b_i = bi[c]; o_re[c] = f2bf(fr * b_r - fi * b_i); o_im[c] = f2bf(fr * b_i + fi * b_r); }
#pragma unroll
        for (int c = 0; c < 16; ++c) { const size_t ci = ((size_t)g * 16 + c) * 64 + p; bf16* cm = C.CMT() + ((size_t)g * 16 + c) * 128;
            *(unsigned*)(cm + 2 * p) = pk2(C.cre()[ci], -C.cim()[ci]); }
    }
    {
        const f32x4* src = (const f32x4*)C.xs(); f32x4* dst = (f32x4*)(C.X1() + (size_t)TP * D);
        for (int i = gt; i < NSMP * D / 4; i += NGT) dst[i] = src[i];
    }
    {
        const f32x4* src = (const f32x4*)C.cs(); f32x4* dst = (f32x4*)(C.out() + O_CONVS);
        for (int i = gt; i < NSMP * 2 * 2048; i += NGT) { const int b = i / 4096, rem = i % 4096, r = rem / 2048, c4 = rem % 2048;
            dst[((size_t)b * 3 + r) * 2048 + c4] = src[((size_t)b * 3 + r + 1) * 2048 + c4]; }
    }
}

template <int CB, int K, class F>
__device__ __forceinline__ void skinny_wave(const bf16* A, int lda, const bf16* Bt, int lane, int rot, F&& epi) {
    const int i16 = lane & 15, q4 = lane >> 4;
    const bf16* ap = A + (size_t)i16 * lda + 8 * q4;
    const bf16* bp = Bt + (size_t)i16 * K + 8 * q4;
    f32x4 acc[CB];
#pragma unroll
    for (int j = 0; j < CB; ++j) acc[j] = (f32x4){0.f, 0.f, 0.f, 0.f};
    constexpr int U = CB == 1 ? 8 : 4;
    constexpr int nst = K / (32 * U); const int kofs = (rot * 32 * U) & (K - 1);
    bf16x8 a[2][U], b[2][CB][U];
#define SK_ISSUE(buf, st) do { const int k_ = (((st) < nst ? (st) : nst - 1) * 32 * U + kofs) & (K - 1); _Pragma("unroll") for (int u = 0; u < U; ++u) { a[buf][u] = *(const bf16x8*)(ap + k_ + 32 * u); \
        _Pragma("unroll") for (int j = 0; j < CB; ++j) b[buf][j][u] = *(const bf16x8*)(bp + (size_t)(16 * j) * K + k_ + 32 * u); } } while (0)
#define SK_MMA(buf) do { _Pragma("unroll") for (int u = 0; u < U; ++u) _Pragma("unroll") for (int j = 0; j < CB; ++j) acc[j] = __builtin_amdgcn_mfma_f32_16x16x32_bf16(b[buf][j][u], a[buf][u], acc[j], 0, 0, 0); } while (0)
    SK_ISSUE(0, 0);
#pragma unroll
    for (int st = 0; st < nst; st += 2) {
        SK_ISSUE(1, st + 1); __builtin_amdgcn_sched_barrier(0); SK_MMA(0); __builtin_amdgcn_sched_barrier(0);
        SK_ISSUE(0, st + 2); __builtin_amdgcn_sched_barrier(0); SK_MMA(1); __builtin_amdgcn_sched_barrier(0);
    }
#undef SK_ISSUE
#undef SK_MMA
#pragma unroll
    for (int j = 0; j < CB; ++j) epi(j, acc[j]);
}
template <int CBT, int CBW, int K, int LDB, class F>
__device__ __forceinline__ void skinny_wg(const bf16* A, int lda, const bf16* Bt, LAS unsigned char* lds, int tid, int jb, int rot, F&& epi) {
    constexpr int U = 8, SK = 32 * U, nst = K / SK, BPITCH = 528, BUFB = CBT * 16 * BPITCH;
    const int lane = tid & 63, i16 = lane & 15, q4 = lane >> 4;
    const bf16* ap = A + (size_t)i16 * lda + 8 * q4;
    const bf16* bg = Bt + (size_t)(tid >> 5) * LDB + (tid & 31) * 8;
    const int bl = (tid >> 5) * BPITCH + (tid & 31) * 16, kofs = (rot * SK) & (K - 1);
    const LAS unsigned char* br = lds + (jb * 16 + i16) * BPITCH + 16 * q4;
    f32x4 acc[CBW];
#pragma unroll
    for (int j = 0; j < CBW; ++j) acc[j] = (f32x4){0.f, 0.f, 0.f, 0.f};
    bf16x8 a[2][U]; v4u breg[CBT];
#define SKG_LOAD(buf, st) do { const int k_ = (((st) < nst ? (st) : nst - 1) * SK + kofs) & (K - 1); \
        _Pragma("unroll") for (int j = 0; j < CBT; ++j) breg[j] = *(const v4u*)(bg + (size_t)(16 * j) * LDB + k_); \
        _Pragma("unroll") for (int u = 0; u < U; ++u) a[buf][u] = *(const bf16x8*)(ap + k_ + 32 * u); } while (0)
    SKG_LOAD(0, 0);
#pragma unroll
    for (int st = 0; st < nst; ++st) {
        const int cb = st & 1;
#pragma unroll
        for (int j = 0; j < CBT; ++j) *(LAS v4u*)(lds + cb * BUFB + j * 16 * BPITCH + bl) = breg[j];
        SKG_LOAD(cb ^ 1, st + 1);
        BAR_LDS();
#pragma unroll
        for (int u = 0; u < U; ++u)
#pragma unroll
            for (int j = 0; j < CBW; ++j) acc[j] = __builtin_amdgcn_mfma_f32_16x16x32_bf16(*(const LAS bf16x8*)(br + cb * BUFB + j * 16 * BPITCH + 64 * u), a[cb][u], acc[j], 0, 0, 0);
    }
#undef SKG_LOAD
#pragma unroll
    for (int j = 0; j < CBW; ++j) epi(j, acc[j]);
}
__device__ __forceinline__ v2u pk4(const f32x4 v) { v2u w; w.x = pk2(v[0], v[1]); w.y = pk2(v[2], v[3]); return w; }

__device__ __forceinline__ bf16x8 afrag(const LAS unsigned char* p) {
    const v2u lo = *(const LAS v2u*)p, hi = *(const LAS v2u*)(p + 16); const v4u r = {lo.x, lo.y, hi.x, hi.y}; return __builtin_bit_cast(bf16x8, r);
}
__device__ __forceinline__ bf16x8 pack_half(const f32x16& X, int sub) {
    v4u r; r.x = pk2(X[8 * sub], X[8 * sub + 1]); r.y = pk2(X[8 * sub + 2], X[8 * sub + 3]); r.z = pk2(X[8 * sub + 4], X[8 * sub + 5]); r.w = pk2(X[8 * sub + 6], X[8 * sub + 7]);
    return __builtin_bit_cast(bf16x8, r);
}
constexpr int PQ_QL = 0, PQ_KL = 17408, PQ_KT = 34816, PQ_VT = 53248, PQ_KK = 90112, PQ_QK = 107520, PQ_LS0 = 124928, PQ_MISC = 142336;
constexpr int QL_PITCH = 272, KT_PITCH = 144, TB_PITCH = 136, KK_PITCH = 68;
__device__ __forceinline__ void gdn_prep_load(const Ctx& C, int unit, int tid, unsigned (&raw)[35], unsigned (&rab)[2]) {
    const int n = unit & 31, hq = (unit >> 5) & 15, b = unit >> 9, tensor = tid >> 7, cp = tid & 63, rh = (tid >> 6) & 1, lane = tid & 63;
    const size_t m0 = (size_t)b * SEQ + (size_t)n * 64;
    const int cidx = (tensor == 0 ? hq * 128 : tensor == 1 ? 2048 + hq * 128 : 4096 + (2 * hq + tensor - 2) * 128) + 2 * cp;
    const bf16* pc = C.P1() + (m0 + rh * 32) * N1P + cidx;
    const bool halo = n > 0 || rh > 0;
#pragma unroll
    for (int i = 0; i < 3; ++i) raw[i] = halo ? *(const unsigned*)(pc - (3 - i) * (ptrdiff_t)N1P) : 0u;
#pragma unroll
    for (int i = 0; i < 32; ++i) raw[3 + i] = *(const unsigned*)(pc + (size_t)i * N1P);
    if (tid < 128) { const bf16* pr = C.P1() + (m0 + lane) * N1P; const int hvw = 2 * hq + (tid >> 6); rab[0] = pr[OFF_A + hvw]; rab[1] = pr[OFF_B + hvw]; }
}
__device__ __forceinline__ void gdn_prep_unit(const Ctx& C, LAS unsigned char* lds, int unit, int next_unit, int tid_in, unsigned (&raw)[35], unsigned (&rab)[2]) {
    int tid = tid_in; asm volatile("" : "+v"(tid));
    const int lane = tid & 63, wave = __builtin_amdgcn_readfirstlane(tid >> 6);
    const int n = unit & 31, hq = (unit >> 5) & 15, b = unit >> 9;
    const int tensor = tid >> 7, ch = tid & 127;
    const size_t m0 = (size_t)b * SEQ + (size_t)n * 64;
    LAS float* KKs = (LAS float*)(lds + PQ_KK); LAS float* QKs = (LAS float*)(lds + PQ_QK); LAS float* Ls0 = (LAS float*)(lds + PQ_LS0);
    LAS float* gcS = (LAS float*)(lds + PQ_MISC); LAS float* betaS = gcS + 128; LAS float* rnq = gcS + 256; LAS float* rnk = gcS + 320;
    LAS float* f1 = gcS + 384;
    if (wave < 2) {
        const int hvw = 2 * hq + wave;
        const float av = bf2f((unsigned short)rab[0]), bv = bf2f((unsigned short)rab[1]);
        const float xx = av + C.dtb()[hvw]; const float sp = xx > 20.f ? xx : log1pf(__expf(xx));
        float g = -__expf(C.alog()[hvw]) * sp;
#pragma unroll
        for (int o = 1; o < 64; o <<= 1) { const float t = __shfl_up(g, o); if (lane >= o) g += t; }
        gcS[wave * 64 + lane] = g; betaS[wave * 64 + lane] = sigmoidf_(bv);
    }
    const int cp = tid & 63, rh = (tid >> 6) & 1;
    float xa[32], xb[32];
    {
        const int cidx = (tensor == 0 ? hq * 128 : tensor == 1 ? 2048 + hq * 128 : 4096 + (2 * hq + tensor - 2) * 128) + 2 * cp;
        const float* cw = C.convw() + cidx;
        const f32x2_t w0 = *(const f32x2_t*)cw, w1 = *(const f32x2_t*)(cw + 8192), w2 = *(const f32x2_t*)(cw + 2 * 8192), w3 = *(const f32x2_t*)(cw + 3 * 8192);
        const unsigned p3 = raw[0], p2 = raw[1], p1 = raw[2];
        float a3 = lo_bf(p3), a2 = lo_bf(p2), a1 = lo_bf(p1), b3 = hi_bf(p3), b2 = hi_bf(p2), b1 = hi_bf(p1);
#pragma unroll
        for (int i = 0; i < 32; ++i) { const unsigned pv = raw[3 + i]; const float ai = lo_bf(pv), bi = hi_bf(pv);
            xa[i] = siluf_(w0.x * a3 + w1.x * a2 + w2.x * a1 + w3.x * ai); xb[i] = siluf_(w0.y * b3 + w1.y * b2 + w2.y * b1 + w3.y * bi);
            a3 = a2; a2 = a1; a1 = ai; b3 = b2; b2 = b1; b1 = bi; }
        if (tensor < 2) {
            LAS unsigned* dst = (LAS unsigned*)(lds + (tensor ? PQ_KL : PQ_QL) + (rh * 32) * QL_PITCH) + cp;
#pragma unroll
            for (int i = 0; i < 32; ++i) dst[i * (QL_PITCH / 4)] = pk2(xa[i], xb[i]);
            if (tensor == 1) { LAS v4u* kta = (LAS v4u*)(lds + PQ_KT + (2 * cp) * KT_PITCH + rh * 64); LAS v4u* ktb = (LAS v4u*)(lds + PQ_KT + (2 * cp + 1) * KT_PITCH + rh * 64);
#pragma unroll
                for (int q = 0; q < 4; ++q) { v4u w; w.x = pk2(xa[8 * q], xa[8 * q + 1]); w.y = pk2(xa[8 * q + 2], xa[8 * q + 3]); w.z = pk2(xa[8 * q + 4], xa[8 * q + 5]); w.w = pk2(xa[8 * q + 6], xa[8 * q + 7]); kta[q] = w;
                    v4u u; u.x = pk2(xb[8 * q], xb[8 * q + 1]); u.y = pk2(xb[8 * q + 2], xb[8 * q + 3]); u.z = pk2(xb[8 * q + 4], xb[8 * q + 5]); u.w = pk2(xb[8 * q + 6], xb[8 * q + 7]); ktb[q] = u; } }
        }
    }
    BAR_LDS();
    if (tensor >= 2) {
        const int e = tensor - 2; const LAS float* be = betaS + e * 64 + rh * 32;
        LAS v4u* vta = (LAS v4u*)(lds + PQ_VT + (e * 128 + 2 * cp) * KT_PITCH + rh * 64); LAS v4u* vtb = (LAS v4u*)(lds + PQ_VT + (e * 128 + 2 * cp + 1) * KT_PITCH + rh * 64);
#pragma unroll
        for (int q = 0; q < 4; ++q) { v4u w; w.x = pk2(xa[8 * q] * be[8 * q], xa[8 * q + 1] * be[8 * q + 1]); w.y = pk2(xa[8 * q + 2] * be[8 * q + 2], xa[8 * q + 3] * be[8 * q + 3]);
            w.z = pk2(xa[8 * q + 4] * be[8 * q + 4], xa[8 * q + 5] * be[8 * q + 5]); w.w = pk2(xa[8 * q + 6] * be[8 * q + 6], xa[8 * q + 7] * be[8 * q + 7]); vta[q] = w;
            v4u u; u.x = pk2(xb[8 * q] * be[8 * q], xb[8 * q + 1] * be[8 * q + 1]); u.y = pk2(xb[8 * q + 2] * be[8 * q + 2], xb[8 * q + 3] * be[8 * q + 3]);
            u.z = pk2(xb[8 * q + 4] * be[8 * q + 4], xb[8 * q + 5] * be[8 * q + 5]); u.w = pk2(xb[8 * q + 6] * be[8 * q + 6], xb[8 * q + 7] * be[8 * q + 7]); vtb[q] = u; }
    }
    {
        const int mat = wave >> 2, ti = (wave >> 1) & 1, tj = wave & 1, c32 = lane & 31, h = lane >> 5;
        const LAS unsigned char* Ab = lds + (mat ? PQ_QL : PQ_KL) + (32 * ti + c32) * QL_PITCH + h * 16;
        const LAS unsigned char* Bb = lds + PQ_KL + (32 * tj + c32) * QL_PITCH + h * 16;
        f32x16 acc;
#pragma unroll
        for (int r = 0; r < 16; ++r) acc[r] = 0.f;
#pragma unroll
        for (int s = 0; s < 8; ++s) { const bf16x8 a = *(const LAS bf16x8*)(Ab + s * 32), bb = *(const LAS bf16x8*)(Bb + s * 32); acc = MFMA32(a, bb, acc); }
        LAS float* Ot = mat ? QKs : KKs;
#pragma unroll
        for (int r = 0; r < 16; ++r) { const int row = 32 * ti + (r & 3) + 8 * (r >> 2) + 4 * h; Ot[row * KK_PITCH + 32 * tj + c32] = acc[r]; }
        if (mat == 0 && ti == tj) {
#pragma unroll
            for (int r = 0; r < 16; ++r) if (((r & 3) + 8 * (r >> 2) + 4 * h) == c32) rnk[32 * ti + c32] = 1.f / sqrtf(acc[r] + 1e-6f);
        }
        if (wave < 2) {
            const LAS unsigned char* Qb = lds + PQ_QL + (32 * wave + c32) * QL_PITCH + h * 16;
            f32x16 qq;
#pragma unroll
            for (int r = 0; r < 16; ++r) qq[r] = 0.f;
#pragma unroll
            for (int s = 0; s < 8; ++s) { const bf16x8 a = *(const LAS bf16x8*)(Qb + s * 32); qq = MFMA32(a, a, qq); }
#pragma unroll
            for (int r = 0; r < 16; ++r) if (((r & 3) + 8 * (r >> 2) + 4 * h) == c32) rnq[32 * wave + c32] = 0.08838834764831845f / sqrtf(qq[r] + 1e-6f);
        }
    }
    BAR_LDS();
    if (tid < 128) { const int e = tid >> 6, i = tid & 63; const float gc = gcS[tid], gl = gcS[e * 64 + 63], eg = __expf(gc);
        f1[tid] = rnq[i] * eg; f1[128 + tid] = rnk[i] * __expf(gl - gc); f1[256 + tid] = betaS[tid] * rnk[i] * eg; }
    BAR_LDS();
    const LAS float* f2 = f1 + 128; const LAS float* f3 = f1 + 256;
    {
        unsigned char* rec0 = C.REC() + (size_t)((b * 32 + 2 * hq) * 32 + n) * REC_BYTES;
#pragma unroll
        for (int r = 0; r < 2; ++r) { const int it = tid + 512 * r, i = it >> 4, j0 = (it & 15) * 4;
            const f32x4 kk4 = *(const LAS f32x4*)(KKs + i * KK_PITCH + j0), qk4 = *(const LAS f32x4*)(QKs + i * KK_PITCH + j0);
            const float rki = rnk[i], rqi = rnq[i], g0i = gcS[i], g1i = gcS[64 + i], b0i = betaS[i], b1i = betaS[64 + i];
            f32x4 l0, l1; float a0[4], a1[4];
#pragma unroll
            for (int t = 0; t < 4; ++t) { const int j = j0 + t; const float rkj = rnk[j];
                const float kk = kk4[t] * rki * rkj, qk = qk4[t] * rqi * rkj, d0 = __expf(g0i - gcS[j]), d1 = __expf(g1i - gcS[64 + j]);
                l0[t] = j < i ? b0i * kk * d0 : 0.f; l1[t] = j < i ? b1i * kk * d1 : 0.f; a0[t] = j <= i ? qk * d0 : 0.f; a1[t] = j <= i ? qk * d1 : 0.f; }
            *(LAS f32x4*)(Ls0 + i * KK_PITCH + j0) = l0; *(LAS f32x4*)(KKs + i * KK_PITCH + j0) = l1;
            v2u w0; w0.x = pk2(a0[0], a0[1]); w0.y = pk2(a0[2], a0[3]); v2u w1; w1.x = pk2(a1[0], a1[1]); w1.y = pk2(a1[2], a1[3]);
            *(v2u*)(rec0 + REC_AT + (i * 64 + j0) * 2) = w0; *(v2u*)(rec0 + (size_t)32 * REC_BYTES + REC_AT + (i * 64 + j0) * 2) = w1; }
#pragma unroll
        for (int r = 0; r < 4; ++r) { const int it = tid + 512 * r, e = it >> 10, rem = it & 1023, i = rem >> 4, d8 = rem & 15;
            const v4u qv = *(const LAS v4u*)(lds + PQ_QL + i * QL_PITCH + d8 * 16); const float sc = f1[e * 64 + i];
            v4u w; w.x = pk2(lo_bf(qv.x) * sc, hi_bf(qv.x) * sc); w.y = pk2(lo_bf(qv.y) * sc, hi_bf(qv.y) * sc); w.z = pk2(lo_bf(qv.z) * sc, hi_bf(qv.z) * sc); w.w = pk2(lo_bf(qv.w) * sc, hi_bf(qv.w) * sc);
            *(v4u*)(rec0 + (size_t)e * 32 * REC_BYTES + REC_QD + i * 256 + d8 * 16) = w; }
#pragma unroll
        for (int r = 0; r < 4; ++r) { const int it = tid + 512 * r, e = it >> 10, rem = it & 1023, d = rem >> 3, i8 = rem & 7;
            const v4u kv = *(const LAS v4u*)(lds + PQ_KT + d * KT_PITCH + i8 * 16); const LAS float* sc = f2 + e * 64 + 8 * i8;
            v4u w; w.x = pk2(lo_bf(kv.x) * sc[0], hi_bf(kv.x) * sc[1]); w.y = pk2(lo_bf(kv.y) * sc[2], hi_bf(kv.y) * sc[3]); w.z = pk2(lo_bf(kv.z) * sc[4], hi_bf(kv.z) * sc[5]); w.w = pk2(lo_bf(kv.w) * sc[6], hi_bf(kv.w) * sc[7]);
            *(v4u*)(rec0 + (size_t)e * 32 * REC_BYTES + REC_KDT + d * 128 + i8 * 16) = w; }
        if (tid < 2) C.GL()[(b * 32 + 2 * hq + tid) * 32 + n] = __expf(gcS[tid * 64 + 63]);
    }
    BAR_LDS();
    if (next_unit >= 0) gdn_prep_load(C, next_unit, tid, raw, rab);
    if (wave < 2) {
        const int c32 = lane & 31, hb = lane >> 5;
        const LAS float* Lm = wave ? KKs : Ls0;
        const LAS float* L = Lm + (hb * 32) * KK_PITCH + hb * 32;
        float t[32];
#pragma unroll
        for (int i = 0; i < 32; ++i) {
            float s0 = (i == c32) ? 1.f : 0.f, s1 = 0.f, s2 = 0.f, s3 = 0.f;
#pragma unroll
            for (int j4 = 0; j4 < (i + 3) / 4; ++j4) { const f32x4 l = *(const LAS f32x4*)(L + i * KK_PITCH + 4 * j4);
                if (4 * j4 + 0 < i) s0 -= l.x * t[4 * j4 + 0];
                if (4 * j4 + 1 < i) s1 -= l.y * t[4 * j4 + 1];
                if (4 * j4 + 2 < i) s2 -= l.z * t[4 * j4 + 2];
                if (4 * j4 + 3 < i) s3 -= l.w * t[4 * j4 + 3]; }
            t[i] = (s0 + s1) + (s2 + s3);
        }
        const float sc = f3[wave * 64 + lane];
        LAS unsigned char* T1base = lds + PQ_QL + wave * 8704; LAS unsigned char* T2base = lds + PQ_QK + wave * 8704;
        {
            LAS bf16* T1 = (LAS bf16*)(T1base + (hb * 32) * TB_PITCH) + lane; LAS bf16* T2 = (LAS bf16*)(T2base + (hb * 32) * TB_PITCH) + lane;
#pragma unroll
            for (int i = 0; i < 32; ++i) { T1[i * (TB_PITCH / 2)] = f2bf(t[i]); T2[i * (TB_PITCH / 2)] = f2bf(t[i] * sc); }
            if (hb) { LAS bf16* Z1 = (LAS bf16*)T1base + lane; LAS bf16* Z2 = (LAS bf16*)T2base + lane;
#pragma unroll
                for (int i = 0; i < 32; ++i) { Z1[i * (TB_PITCH / 2)] = 0; Z2[i * (TB_PITCH / 2)] = 0; } }
        }
        if (!hb) { LAS v4u* tt = (LAS v4u*)((LAS unsigned char*)Lm + c32 * (KK_PITCH * 4) + 128);
#pragma unroll
            for (int q = 0; q < 4; ++q) { v4u w; w.x = pk2(t[8 * q], t[8 * q + 1]); w.y = pk2(t[8 * q + 2], t[8 * q + 3]); w.z = pk2(t[8 * q + 4], t[8 * q + 5]); w.w = pk2(t[8 * q + 6], t[8 * q + 7]); tt[q] = w; } }
        f32x16 M;
#pragma unroll
        for (int r = 0; r < 16; ++r) M[r] = 0.f;
#pragma unroll
        for (int s2 = 0; s2 < 2; ++s2) {
            const LAS f32x4* lp = (const LAS f32x4*)(Lm + (32 + c32) * KK_PITCH + 16 * s2 + 8 * hb); const f32x4 la = lp[0], lb = lp[1];
            v4u av; av.x = pk2(la.x, la.y); av.y = pk2(la.z, la.w); av.z = pk2(lb.x, lb.y); av.w = pk2(lb.z, lb.w);
            const bf16x8 bv = *(const LAS bf16x8*)((const LAS unsigned char*)Lm + c32 * (KK_PITCH * 4) + 128 + (16 * s2 + 8 * hb) * 2);
            M = MFMA32(__builtin_bit_cast(bf16x8, av), bv, M); }
        f32x16 T21;
#pragma unroll
        for (int r = 0; r < 16; ++r) T21[r] = 0.f;
#pragma unroll
        for (int s2 = 0; s2 < 2; ++s2) T21 = MFMA32(afrag(T1base + (32 + c32) * TB_PITCH + (32 + 16 * s2 + 4 * hb) * 2), pack_half(M, s2), T21);
        {   const float sc21 = f3[wave * 64 + c32];
            LAS bf16* T1 = (LAS bf16*)(T1base + (32 + 4 * hb) * TB_PITCH) + c32; LAS bf16* T2 = (LAS bf16*)(T2base + (32 + 4 * hb) * TB_PITCH) + c32;
#pragma unroll
            for (int r = 0; r < 16; ++r) { const int ro = ((r & 3) + 8 * (r >> 2)) * (TB_PITCH / 2); T1[ro] = f2bf(-T21[r]); T2[ro] = f2bf(-T21[r] * sc21); } }
    }
    BAR_LDS();
    {
        const int e = wave >> 2, ct = wave & 3, c32 = lane & 31, h = lane >> 5;
        unsigned char* rec = C.REC() + (size_t)((b * 32 + 2 * hq + e) * 32 + n) * REC_BYTES;
        const LAS unsigned char* Bv = lds + PQ_VT + (e * 128 + 32 * ct + c32) * KT_PITCH + h * 16;
        const LAS unsigned char* Bk = lds + PQ_KT + (32 * ct + c32) * KT_PITCH + h * 16;
#pragma unroll
        for (int t = 0; t < 2; ++t) {
            const LAS unsigned char* A1 = lds + PQ_QL + e * 8704 + (32 * t + c32) * TB_PITCH + h * 16;
            const LAS unsigned char* A2 = lds + PQ_QK + e * 8704 + (32 * t + c32) * TB_PITCH + h * 16;
            f32x16 au, aw;
#pragma unroll
            for (int r = 0; r < 16; ++r) { au[r] = 0.f; aw[r] = 0.f; }
#pragma unroll
            for (int s = 0; s < 4; ++s) {
                const v2u a1l = *(const LAS v2u*)(A1 + s * 32), a1h = *(const LAS v2u*)(A1 + s * 32 + 8), a2l = *(const LAS v2u*)(A2 + s * 32), a2h = *(const LAS v2u*)(A2 + s * 32 + 8);
                const v4u a1 = {a1l.x, a1l.y, a1h.x, a1h.y}, a2 = {a2l.x, a2l.y, a2h.x, a2h.y};
                au = MFMA32(__builtin_bit_cast(bf16x8, a1), *(const LAS bf16x8*)(Bv + s * 32), au);
                aw = MFMA32(*(const LAS bf16x8*)(Bk + s * 32), __builtin_bit_cast(bf16x8, a2), aw); }
            unsigned char* ut = rec + REC_UT + (32 * ct + c32) * 128 + (32 * t + 4 * h) * 2;
#pragma unroll
            for (int g4 = 0; g4 < 4; ++g4) { v2u w; w.x = pk2(au[4 * g4], au[4 * g4 + 1]); w.y = pk2(au[4 * g4 + 2], au[4 * g4 + 3]); *(v2u*)(ut + 16 * g4) = w; }
            unsigned char* wn = rec + REC_WN + ((32 * t + c32) * 128 + 32 * ct + 4 * h) * 2;
#pragma unroll
            for (int g4 = 0; g4 < 4; ++g4) { v2u w; w.x = pk2(-aw[4 * g4], -aw[4 * g4 + 1]); w.y = pk2(-aw[4 * g4 + 2], -aw[4 * g4 + 3]); *(v2u*)(wn + 16 * g4) = w; }
        }
    }
    BAR_LDS();
}
__device__ __forceinline__ void phase2(const Ctx& C, LAS unsigned char* lds) {
    {   const int tid = fresh_tid(); unsigned raw[35], rab[2] = {0u, 0u};
        if ((int)blockIdx.x < NB * 16 * 32) gdn_prep_load(C, blockIdx.x, tid, raw, rab);
#pragma unroll 1
        for (int u = blockIdx.x; u < NB * 16 * 32; u += gridDim.x) { const int nu = u + (int)gridDim.x; gdn_prep_unit(C, lds, u, nu < NB * 16 * 32 ? nu : -1, tid, raw, rab); } }
    const int gt = blockIdx.x * 512 + fresh_tid(), NGT = gridDim.x * 512;
    for (int i = gt; i < (NB * 3 + NSMP) * 4096; i += NGT) { const int rr = i >> 12, c2 = i & 4095;
        size_t m; float* dst;
        if (rr < NB * 3) { const int b = rr / 3, r = rr % 3; m = (size_t)b * SEQ + SEQ - 3 + r; dst = C.out() + O_CONVP + (size_t)rr * 8192; }
        else { const int b = rr - NB * 3; m = TP + b; dst = C.out() + O_CONVS + ((size_t)b * 3 + 2) * 8192; }
        const unsigned v = *(const unsigned*)(C.P1() + m * N1P + 2 * c2);
        f32x2_t o = {lo_bf(v), hi_bf(v)}; *(f32x2_t*)(dst + 2 * c2) = o; }
}

constexpr int SC_SLOT = 62464, SC_WNQD = 0, SC_ATK = 34816, SC_OBUF = 2 * SC_SLOT, SC_PITCH_A = 272, SC_PITCH_B = 144;
__device__ __forceinline__ void gdn_scan_unit(const Ctx& C, LAS unsigned char* lds, int bh) {
    const int tid = fresh_tid(), lane = tid & 63, wave = __builtin_amdgcn_readfirstlane(tid >> 6), c32 = lane & 31, h = lane >> 5;
    const int b = bh >> 5, hv = bh & 31;
    const unsigned char* rec0 = C.REC() + (size_t)bh * 32 * REC_BYTES;
    f32x16 S[4];
#pragma unroll
    for (int T = 0; T < 4; ++T)
#pragma unroll
        for (int r = 0; r < 16; ++r) S[T][r] = 0.f;
    const int lt = tid & 255;
    const int ldA = SC_WNQD + (lt >> 4) * SC_PITCH_A + (lt & 15) * 16, ldB = SC_ATK + (lt >> 3) * SC_PITCH_B + (lt & 7) * 16;
    if (wave >= 4) {
#pragma unroll
        for (int r = 0; r < 14; ++r) { const v4u v = *(const v4u*)(rec0 + 16 * lt + 4096 * r);
            *(LAS v4u*)(lds + (r < 8 ? ldA + r * 16 * SC_PITCH_A : ldB + (r - 8) * 32 * SC_PITCH_B)) = v; } }
    BAR_LDS();
    for (int n = 0; n < 32; ++n) {
        const unsigned char* rec = rec0 + (size_t)n * REC_BYTES;
        const LAS unsigned char* slot = lds + (n & 1) * SC_SLOT;
        const int ntok = tid >> 3, nseg = tid & 7; const size_t nm = (size_t)b * SEQ + n * 64 + ntok;
        const v4u* zp = (const v4u*)(C.P1() + nm * N1P + NZ + hv * 128 + nseg * 16); const v4u z0 = zp[0], z1 = zp[1];
        if (wave >= 4) {
            if (n < 31) { const unsigned char* nrec = rec + REC_BYTES; LAS unsigned char* ns = lds + ((n + 1) & 1) * SC_SLOT;
                v4u v[14];
#pragma unroll
                for (int r = 0; r < 14; ++r) v[r] = *(const v4u*)(nrec + 16 * lt + 4096 * r);
#pragma unroll
                for (int r = 0; r < 14; ++r) *(LAS v4u*)(ns + (r < 8 ? ldA + r * 16 * SC_PITCH_A : ldB + (r - 8) * 32 * SC_PITCH_B)) = v[r]; }
        } else {
            __builtin_amdgcn_s_setprio(1);
            const int dv = 32 * wave + c32;
            f32x16 V[2], O[2];
            {
                const unsigned char* ut = rec + REC_UT + dv * 128 + h * 8;
#pragma unroll
                for (int t = 0; t < 2; ++t)
#pragma unroll
                    for (int g4 = 0; g4 < 4; ++g4) { const v2u w = *(const v2u*)(ut + (32 * t + 8 * g4) * 2);
                        V[t][4 * g4 + 0] = lo_bf(w.x); V[t][4 * g4 + 1] = hi_bf(w.x); V[t][4 * g4 + 2] = lo_bf(w.y); V[t][4 * g4 + 3] = hi_bf(w.y); }
#pragma unroll
                for (int t = 0; t < 2; ++t)
#pragma unroll
                    for (int r = 0; r < 16; ++r) O[t][r] = 0.f;
            }
            const float gl = C.GL()[bh * 32 + n];
            const LAS unsigned char* aW = slot + SC_WNQD + c32 * SC_PITCH_A + h * 8;
            const LAS unsigned char* aK = slot + SC_ATK + c32 * SC_PITCH_B + h * 8;
#pragma unroll
            for (int s = 0; s < 8; ++s) { const bf16x8 sb = pack_half(S[s >> 1], s & 1);
                V[0] = MFMA32(afrag(aW + s * 32), sb, V[0]);
                V[1] = MFMA32(afrag(aW + 32 * SC_PITCH_A + s * 32), sb, V[1]);
                O[0] = MFMA32(afrag(aW + 64 * SC_PITCH_A + s * 32), sb, O[0]);
                O[1] = MFMA32(afrag(aW + 96 * SC_PITCH_A + s * 32), sb, O[1]); __builtin_amdgcn_sched_barrier(0); }
#pragma unroll
            for (int T = 0; T < 4; ++T) S[T] = S[T] * gl;
#pragma unroll
            for (int s = 0; s < 4; ++s) { const bf16x8 vb = pack_half(V[s >> 1], s & 1);
                O[0] = MFMA32(afrag(aK + s * 32), vb, O[0]);
                O[1] = MFMA32(afrag(aK + 32 * SC_PITCH_B + s * 32), vb, O[1]);
#pragma unroll
                for (int T = 0; T < 4; ++T) S[T] = MFMA32(afrag(aK + (64 + 32 * T) * SC_PITCH_B + s * 32), vb, S[T]);
                __builtin_amdgcn_sched_barrier(0); }
            LAS bf16* ob = (LAS bf16*)(lds + SC_OBUF) + dv;
#pragma unroll
            for (int t = 0; t < 2; ++t)
#pragma unroll
                for (int r = 0; r < 16; ++r) { const int tok = 32 * t + (r & 3) + 8 * (r >> 2) + 4 * h; ob[tok * (SC_PITCH_A / 2)] = f2bf(O[t][r]); }
            __builtin_amdgcn_s_setprio(0);
        }
        BAR_LDS();
        {
            const int tok = ntok, seg = nseg; const size_t m = nm;
            const LAS v4u* op = (const LAS v4u*)(lds + SC_OBUF + tok * SC_PITCH_A + seg * 32);
            const v4u o0 = op[0], o1 = op[1];
            float o[16] = {lo_bf(o0.x), hi_bf(o0.x), lo_bf(o0.y), hi_bf(o0.y), lo_bf(o0.z), hi_bf(o0.z), lo_bf(o0.w), hi_bf(o0.w),
                           lo_bf(o1.x), hi_bf(o1.x), lo_bf(o1.y), hi_bf(o1.y), lo_bf(o1.z), hi_bf(o1.z), lo_bf(o1.w), hi_bf(o1.w)};
            float ss = 0.f;
#pragma unroll
            for (int i = 0; i < 16; ++i) ss += o[i] * o[i];
            ss += __shfl_xor(ss, 1); ss += __shfl_xor(ss, 2); ss += __shfl_xor(ss, 4);
            const float rs = 1.f / sqrtf(ss * (1.f / 128.f) + RMS_EPS);
            const float z[16] = {lo_bf(z0.x), hi_bf(z0.x), lo_bf(z0.y), hi_bf(z0.y), lo_bf(z0.z), hi_bf(z0.z), lo_bf(z0.w), hi_bf(z0.w),
                                 lo_bf(z1.x), hi_bf(z1.x), lo_bf(z1.y), hi_bf(z1.y), lo_bf(z1.z), hi_bf(z1.z), lo_bf(z1.w), hi_bf(z1.w)};
            const float* gn = C.onorm() + seg * 16;
            float y[16];
#pragma unroll
            for (int i = 0; i < 16; ++i) y[i] = o[i] * rs * gn[i] * siluf_(z[i]);
            v4u w0, w1; w0.x = pk2(y[0], y[1]); w0.y = pk2(y[2], y[3]); w0.z = pk2(y[4], y[5]); w0.w = pk2(y[6], y[7]);
            w1.x = pk2(y[8], y[9]); w1.y = pk2(y[10], y[11]); w1.z = pk2(y[12], y[13]); w1.w = pk2(y[14], y[15]);
            v4u* og = (v4u*)(C.OG() + m * E + hv * 128 + seg * 16); og[0] = w0; og[1] = w1;
        }
        BAR_LDS();
    }
    if (wave < 4) {
        float* dp = C.out() + O_DELTAP + (size_t)bh * 16384 + 32 * wave + c32;
#pragma unroll
        for (int T = 0; T < 4; ++T)
#pragma unroll
            for (int r = 0; r < 16; ++r) { const int dk = 32 * T + (r & 3) + 8 * (r >> 2) + 4 * h; __builtin_nontemporal_store(S[T][r], dp + dk * 128); }
    }
}

__device__ __forceinline__ void gdn_sample_unit(const Ctx& C, LAS unsigned char* lds, int unit) {
    const int tid = fresh_tid(), lane = tid & 63, wave = tid >> 6;
    const int b = unit >> 5, hv = unit & 31, hq = hv >> 1; const size_t m = TP + b;
    LAS float* sv = (LAS float*)lds;
    LAS float* part = (LAS float*)(lds + 2048);
    LAS float* misc = (LAS float*)(lds + 2048 + 8192);
    const bf16* pr = C.P1() + m * N1P;
    const int dv4 = tid & 31, dk0 = tid >> 5;
    const f32x4* Sp = (const f32x4*)(C.ds() + (size_t)unit * 16384) + dv4;
    f32x4 S[8];
#pragma unroll
    for (int r = 0; r < 8; ++r) S[r] = __builtin_nontemporal_load(Sp + (dk0 + 16 * r) * 32);
    if (tid < 384) { const int tensor = tid >> 7, ch = tid & 127;
        const int cidx = tensor == 0 ? hq * 128 + ch : tensor == 1 ? 2048 + hq * 128 + ch : 4096 + hv * 128 + ch;
        const float* st = C.cs() + (size_t)b * 3 * 8192 + cidx;
        const float y = C.convw()[cidx] * st[0] + C.convw()[8192 + cidx] * st[8192] + C.convw()[2 * 8192 + cidx] * st[2 * 8192] + C.convw()[3 * 8192 + cidx] * bf2f(pr[cidx]);
        sv[tid] = siluf_(y); }
    BAR_LDS();
    if (wave < 2) { const float a0 = sv[wave * 128 + lane], a1 = sv[wave * 128 + 64 + lane]; float rn = 1.f / sqrtf(wave_sum(a0 * a0 + a1 * a1) + 1e-6f);
        if (wave == 0) rn *= 0.08838834764831845f;
        sv[wave * 128 + lane] = a0 * rn; sv[wave * 128 + 64 + lane] = a1 * rn; }
    BAR_LDS();
    if (wave == 0) { const float qk = wave_sum(sv[lane] * sv[128 + lane] + sv[64 + lane] * sv[192 + lane]); if (lane == 0) misc[0] = qk; }
    const float av = bf2f(pr[OFF_A + hv]), bv = bf2f(pr[OFF_B + hv]);
    const float xx = av + C.dtb()[hv]; const float sp = xx > 20.f ? xx : log1pf(__expf(xx));
    const float eg = __expf(-__expf(C.alog()[hv]) * sp), beta = sigmoidf_(bv);
    f32x4 ks = {0.f, 0.f, 0.f, 0.f}, qs = {0.f, 0.f, 0.f, 0.f};
#pragma unroll
    for (int r = 0; r < 8; ++r) { const float qd = sv[dk0 + 16 * r], kd = sv[128 + dk0 + 16 * r]; ks += S[r] * kd; qs += S[r] * qd; }
#pragma unroll
    for (int i = 0; i < 4; ++i) { ks[i] += __shfl_xor(ks[i], 32); qs[i] += __shfl_xor(qs[i], 32); }
    if (lane < 32) { *(LAS f32x4*)(part + wave * 128 + 4 * dv4) = ks; *(LAS f32x4*)(part + 1024 + wave * 128 + 4 * dv4) = qs; }
    BAR_LDS();
    ks = (f32x4){0.f, 0.f, 0.f, 0.f}; qs = ks;
#pragma unroll
    for (int w = 0; w < 8; ++w) { ks += *(const LAS f32x4*)(part + w * 128 + 4 * dv4); qs += *(const LAS f32x4*)(part + 1024 + w * 128 + 4 * dv4); }
    const f32x4 vv = *(const LAS f32x4*)(sv + 256 + 4 * dv4); const float qk = misc[0];
    const f32x4 vn = (vv - ks * eg) * beta;
    const f32x4 o = qs * eg + vn * qk;
    f32x4* So = (f32x4*)(C.out() + O_DELTAS + (size_t)unit * 16384) + dv4;
#pragma unroll
    for (int r = 0; r < 8; ++r) { const float kd = sv[128 + dk0 + 16 * r]; __builtin_nontemporal_store(S[r] * eg + vn * kd, So + (dk0 + 16 * r) * 32); }
    if (wave == 0) {
        float ss = o.x * o.x + o.y * o.y + o.z * o.z + o.w * o.w;
        ss += __shfl_xor(ss, 1); ss += __shfl_xor(ss, 2); ss += __shfl_xor(ss, 4); ss += __shfl_xor(ss, 8); ss += __shfl_xor(ss, 16);
        const float rs = 1.f / sqrtf(ss * (1.f / 128.f) + RMS_EPS);
        if (lane < 32) { const v2u zv = *(const v2u*)(pr + NZ + hv * 128 + 4 * dv4); const f32x4 gn = *(const f32x4*)(C.onorm() + 4 * dv4);
            v2u w; w.x = pk2(o.x * rs * gn.x * siluf_(lo_bf(zv.x)), o.y * rs * gn.y * siluf_(hi_bf(zv.x)));
            w.y = pk2(o.z * rs * gn.z * siluf_(lo_bf(zv.y)), o.w * rs * gn.w * siluf_(hi_bf(zv.y)));
            *(v2u*)(C.OG() + m * E + hv * 128 + 4 * dv4) = w; } }
    BAR_LDS();
}
__device__ __forceinline__ void phase3(const Ctx& C, LAS unsigned char* lds) {
    for (int bh = blockIdx.x; bh < NB * 32; bh += gridDim.x) gdn_scan_unit(C, lds, bh);
    LAS int* qslot = (LAS int*)(lds + 16384); const int qt = fresh_tid();
    for (;;) {
        if (qt == 0) *qslot = (int)atomicAdd(C.ctl() + 0, 1u);
        BAR_LDS();
        const int u = *qslot;
        BAR_LDS();
        if (u >= NSMP * 32) break;
        gdn_sample_unit(C, lds, u);
    }
}

constexpr int SS_SLOT = 36864, SS_HS = 17408, SS_HSB = 8704, SS_UL = 34816, SS_HS_PITCH = 272, SS_BU_PITCH = 272;
template <bool SAMPLE>
__device__ __forceinline__ void ssm_round(const Ctx& C, LAS unsigned char* lds, int ubase, int tid) {
    const int lane = tid & 63, wave = __builtin_amdgcn_readfirstlane(tid >> 6), slot = wave & 3, role = wave >> 2;
    const int u = ubase + slot, seq = u >> 8, g = u & 255;
    LAS unsigned char* wl = lds + slot * SS_SLOT;
    const int c32 = lane & 31, h = lane >> 5, c16 = lane & 15, q4 = lane >> 4;
    constexpr int nchunk = SAMPLE ? NSMP / 32 : SEQ / 32;
    const size_t mbase = SAMPLE ? (size_t)TP : (size_t)seq * SEQ;
    if (role == 0) {
        bf16x8 bb[4];
#pragma unroll
        for (int j = 0; j < 4; ++j) bb[j] = *(const bf16x8*)(C.BBT() + ((size_t)g * 128 + 32 * j + c32) * 16 + 8 * h);
        const float ar = C.AR()[g * 64 + lane], ai = C.AI()[g * 64 + lane];
        const f32x2_t A2 = {ar, ar}, B2 = {-ai, ai}; f32x2_t h2 = {0.f, 0.f};
        __builtin_amdgcn_s_setprio(1);
        const bf16* up = C.UZ() + (mbase + c32) * NZ + g * 16 + 8 * h;
        bf16x8 ring[4];
#pragma unroll
        for (int i = 0; i < 4; ++i) ring[i] = __builtin_nontemporal_load((const bf16x8*)(up + (size_t)i * 32 * NZ));
#pragma unroll 1
        for (int ck0 = 0; ck0 < nchunk; ck0 += 4) {
#pragma unroll
            for (int ci = 0; ci < 4; ++ci) { const int ck = ck0 + ci;
                const bf16x8 ua = ring[ci];
                ring[ci] = __builtin_nontemporal_load((const bf16x8*)(up + (size_t)(ck + 4 < nchunk ? ck + 4 : nchunk - 1) * 32 * NZ));
                LAS unsigned char* HS = wl + SS_HS + (ck & 1) * SS_HSB;
                *(LAS bf16x8*)(wl + SS_UL + (ck & 1) * 1024 + c32 * 32 + h * 16) = ua;
#pragma unroll
                for (int j2 = 0; j2 < 2; ++j2) { f32x16 aR, aI;
#pragma unroll
                    for (int r = 0; r < 16; ++r) { aR[r] = 0.f; aI[r] = 0.f; }
                    aR = MFMA32(ua, bb[j2], aR); aI = MFMA32(ua, bb[2 + j2], aI);
                    LAS unsigned char* bp = wl + (32 * j2 + c32) * SS_BU_PITCH + h * 32;
#pragma unroll
                    for (int g4 = 0; g4 < 4; ++g4)
#pragma unroll
                        for (int hh = 0; hh < 2; ++hh) { const int r0 = 4 * g4 + 2 * hh; const f32x4 v = {aR[r0], aI[r0], aR[r0 + 1], aI[r0 + 1]};
                            *(LAS f32x4*)(bp + (4 * g4 + hh) * 16) = v; } }
                {
                    const LAS unsigned char* rp = wl + lane * SS_BU_PITCH;
#pragma unroll
                    for (int q = 0; q < 16; ++q) { const f32x4 v = *(const LAS f32x4*)(rp + q * 16);
                        f32x2_t n0 = A2 * h2 + (B2 * __builtin_shufflevector(h2, h2, 1, 0) + (f32x2_t){v.x, v.y});
                        *(LAS unsigned*)(HS + (2 * q) * SS_HS_PITCH + lane * 4) = pk2(n0.x, n0.y);
                        f32x2_t n1 = A2 * n0 + (B2 * __builtin_shufflevector(n0, n0, 1, 0) + (f32x2_t){v.z, v.w});
                        *(LAS unsigned*)(HS + (2 * q + 1) * SS_HS_PITCH + lane * 4) = pk2(n1.x, n1.y);
                        h2 = n1; }
                }
                BAR_LDS();
            }
        }
        BAR_LDS();
        __builtin_amdgcn_s_setprio(0);
        if (!SAMPLE) { C.out()[O_REP + ((size_t)seq * 256 + g) * 64 + lane] = h2.x; C.out()[O_IMP + ((size_t)seq * 256 + g) * 64 + lane] = h2.y; }
    } else {
        bf16x8 cm[4];
#pragma unroll
        for (int s = 0; s < 4; ++s) cm[s] = *(const bf16x8*)(C.CMT() + ((size_t)g * 16 + c16) * 128 + 32 * s + 8 * q4);
        const float dsk = C.dssm()[g * 16 + c16];
        bf16* ygw = C.YG() + (mbase + (lane >> 1)) * E + g * 16 + (lane & 1) * 8;
        BAR_LDS();
#pragma unroll 1
        for (int cc = 0; cc < nchunk; ++cc) {
            {
                const LAS unsigned char* HS = wl + SS_HS + (cc & 1) * SS_HSB; const LAS unsigned char* UL = wl + SS_UL + (cc & 1) * 1024;
                LAS unsigned char* YL = wl + SS_HS + (cc & 1) * SS_HSB;
#pragma unroll
                for (int tt = 0; tt < 2; ++tt) { f32x4 y = {0.f, 0.f, 0.f, 0.f};
#pragma unroll
                    for (int s = 0; s < 4; ++s) { const bf16x8 a = *(const LAS bf16x8*)(HS + (16 * tt + c16) * SS_HS_PITCH + s * 64 + q4 * 16);
                        y = __builtin_amdgcn_mfma_f32_16x16x32_bf16(a, cm[s], y, 0, 0, 0); }
#pragma unroll
                    for (int r = 0; r < 4; ++r) { const int row = 16 * tt + 4 * q4 + r;
                        const float uv = bf2f(*(const LAS bf16*)(UL + row * 32 + c16 * 2));
                        *(LAS bf16*)(YL + row * 32 + c16 * 2) = f2bf(gelu_tanh(y[r] + dsk * uv)); } }
                *(v4u*)(ygw + (size_t)(cc * 32) * E) = *(const LAS v4u*)(YL + lane * 16); }
            BAR_LDS();
        }
    }
}
__device__ __forceinline__ void ssm_sample_unit(const Ctx& C, LAS unsigned char* wl, int g, int rb, int lane_in) {
    int lane = lane_in; asm volatile("" : "+v"(lane));
    const int c32 = lane & 31, h = lane >> 5, c16 = lane & 15, q4 = lane >> 4;
    const size_t m0 = (size_t)TP + rb * 32;
    const size_t sbase = ((size_t)(rb * 32) * 256 + g) * 64;
    const float* pr = C.sre() + sbase; const float* pi = C.sim() + sbase;
    float h0r[16], h0i[16];
#pragma unroll
    for (int r = 0; r < 16; ++r) { h0r[r] = __builtin_nontemporal_load((const float*)((const char*)pr + (unsigned)(r * 65536 + lane * 4))); h0i[r] = __builtin_nontemporal_load((const float*)((const char*)pi + (unsigned)(r * 65536 + lane * 4))); }
    const bf16x8 ua = *(const bf16x8*)(C.UZ() + (m0 + c32) * NZ + g * 16 + 8 * h);
    bf16x8 bb[4], cm[4];
#pragma unroll
    for (int j = 0; j < 4; ++j) bb[j] = *(const bf16x8*)(C.BBT() + ((size_t)g * 128 + 32 * j + c32) * 16 + 8 * h);
#pragma unroll
    for (int s = 0; s < 4; ++s) cm[s] = *(const bf16x8*)(C.CMT() + ((size_t)g * 16 + c16) * 128 + 32 * s + 8 * q4);
    const float ar = C.AR()[g * 64 + lane], ai = C.AI()[g * 64 + lane], dsk = C.dssm()[g * 16 + c16];
    LAS unsigned char* HS = wl + SS_HS; LAS unsigned char* UL = wl + SS_UL;
    *(LAS bf16x8*)(UL + c32 * 32 + h * 16) = ua;
#pragma unroll
    for (int j2 = 0; j2 < 2; ++j2) { f32x16 aR, aI;
#pragma unroll
        for (int r = 0; r < 16; ++r) { aR[r] = 0.f; aI[r] = 0.f; }
        aR = MFMA32(ua, bb[j2], aR); aI = MFMA32(ua, bb[2 + j2], aI);
        LAS unsigned char* bp = wl + (32 * j2 + c32) * SS_BU_PITCH + h * 32;
#pragma unroll
        for (int g4 = 0; g4 < 4; ++g4)
#pragma unroll
            for (int hh = 0; hh < 2; ++hh) { const int r0 = 4 * g4 + 2 * hh; const f32x4 v = {aR[r0], aI[r0], aR[r0 + 1], aI[r0 + 1]};
                *(LAS f32x4*)(bp + (4 * g4 + hh) * 16) = v; } }
    float* orp = C.out() + O_RES + sbase; float* oip = C.out() + O_IMS + sbase;
    const LAS unsigned char* rp = wl + lane * SS_BU_PITCH;
#pragma unroll
    for (int q = 0; q < 16; ++q) { const f32x4 v = *(const LAS f32x4*)(rp + q * 16);
        if (q == 8) {
#pragma unroll
            for (int r = 0; r < 16; ++r) { h0r[r] = *(const float*)((const char*)pr + (unsigned)((16 + r) * 65536 + lane * 4)); h0i[r] = *(const float*)((const char*)pi + (unsigned)((16 + r) * 65536 + lane * 4)); } }
#pragma unroll
        for (int e = 0; e < 2; ++e) { const int r = 2 * q + e; const float re = e ? v.z : v.x, im = e ? v.w : v.y;
            const float nr = ar * h0r[r & 15] - ai * h0i[r & 15] + re, ni = ar * h0i[r & 15] + ai * h0r[r & 15] + im;
            __builtin_nontemporal_store(nr, (float*)((char*)orp + (unsigned)(r * 65536 + lane * 4))); __builtin_nontemporal_store(ni, (float*)((char*)oip + (unsigned)(r * 65536 + lane * 4)));
            *(LAS unsigned*)(HS + r * SS_HS_PITCH + lane * 4) = pk2(nr, ni); } }
    bf16* yg = C.YG() + (m0 + 4 * q4) * E + g * 16 + c16;
#pragma unroll
    for (int tt = 0; tt < 2; ++tt) { f32x4 y = {0.f, 0.f, 0.f, 0.f};
#pragma unroll
        for (int s = 0; s < 4; ++s) { const bf16x8 a = *(const LAS bf16x8*)(HS + (16 * tt + c16) * SS_HS_PITCH + s * 64 + q4 * 16);
            y = __builtin_amdgcn_mfma_f32_16x16x32_bf16(a, cm[s], y, 0, 0, 0); }
#pragma unroll
        for (int r = 0; r < 4; ++r) { const int row = 16 * tt + 4 * q4 + r;
            const float uv = bf2f(*(const LAS bf16*)(UL + row * 32 + c16 * 2));
            yg[(size_t)(16 * tt + r) * E] = f2bf(gelu_tanh(y[r] + dsk * uv)); } }
}
__device__ __forceinline__ void phase7(const Ctx& C, LAS unsigned char* lds) {
    const int tid = fresh_tid();
    for (int ub = blockIdx.x * 4; ub < NB * 256; ub += gridDim.x * 4) ssm_round<false>(C, lds, ub, tid);
    const int lane = tid & 63, wave = __builtin_amdgcn_readfirstlane(tid >> 6);
    if (wave < 4) for (int u = blockIdx.x * 4 + wave; u < 1024; u += gridDim.x * 4) ssm_sample_unit(C, lds + wave * SS_SLOT, u & 255, u >> 8, lane);
}
__device__ __forceinline__ void grid_bar(unsigned* cnt, unsigned target) {
    __syncthreads();
    if (threadIdx.x == 0) {
        __builtin_amdgcn_fence(__ATOMIC_RELEASE, "agent");
        asm volatile("s_waitcnt vmcnt(0)" ::: "memory");
        __hip_atomic_fetch_add(cnt, 1u, __ATOMIC_RELAXED, __HIP_MEMORY_SCOPE_AGENT);
        unsigned spins = 0;
        while (__hip_atomic_load(cnt, __ATOMIC_RELAXED, __HIP_MEMORY_SCOPE_AGENT) < target && ++spins < (1u << 24)) __builtin_amdgcn_s_sleep(2);
        __builtin_amdgcn_fence(__ATOMIC_ACQUIRE, "agent");
    }
    __syncthreads();
}
__global__ void __launch_bounds__(512, 2) mk_fwd(Args a) {
    extern __shared__ __attribute__((aligned(16))) unsigned char lds_raw[];
    LAS unsigned char* lds = (LAS unsigned char*)lds_raw;
    cg::grid_group grid = cg::this_grid();
    const Ctx C{a};
    const int lo = a.ph_lo, hi = a.ph_hi; unsigned nbar = 0;
#ifdef ONLY
#define IN(k) ((k) == ONLY && lo <= (k) && (k) < hi)
#else
#define IN(k) (lo <= (k) && (k) < hi)
#endif
#define SEAM(k) do { if (IN(k) && IN((k) + 1)) { if ((k) == 0) grid.sync(); else { ++nbar; grid_bar(C.ctl() + 64, nbar * gridDim.x); } } } while (0)
    if (IN(0)) phase0(C, lds);
    SEAM(0);
    if (IN(1)) { pg8::Gemm g{C.H(), C.WT1(), TP, 12288, D}; pg8::StaticOrder S; S.init(TP, 12288, (int)gridDim.x, (int)blockIdx.x);
        EpiStore Ep{C.P1(), N1P}; if (!(a.flags & 2)) pg8::gemm_phase<EpiStore, pg8::StaticOrder, true, true>(lds, g, S, Ep);
        const int t1 = fresh_tid(), lane = t1 & 63, wave = __builtin_amdgcn_readfirstlane(t1 >> 6), i16 = lane & 15, q4 = lane >> 4;
        if (!(a.flags & 1)) {
            bf16* P1 = C.P1();
            for (int job = blockIdx.x; job < TP / 32; job += gridDim.x) { const int r0 = job * 32 + (wave >> 2) * 16, c0 = OFF_B + (wave & 3) * 16;
                skinny_wg<4, 1, D, D>(C.H() + (size_t)r0 * D, D, C.WT1() + (size_t)OFF_B * D, lds, t1, wave & 3, job >> 3, [&](int j, const f32x4 v) {
                    *(v2u*)(P1 + (size_t)(r0 + i16) * N1P + c0 + 4 * q4) = pk4(v); }); }
            for (int job = blockIdx.x; job < N1 / 64; job += gridDim.x) { const int r0 = TP + wave * 16, c0 = job * 64;
                skinny_wg<4, 4, D, D>(C.H() + (size_t)r0 * D, D, C.WT1() + (size_t)c0 * D, lds, t1, 0, job >> 3, [&](int j, const f32x4 v) {
                    *(v2u*)(P1 + (size_t)(r0 + i16) * N1P + c0 + 16 * j + 4 * q4) = pk4(v); }); }
        } }
    SEAM(1);
    if (IN(2)) phase2(C, lds);
    SEAM(2);
    if (IN(3)) phase3(C, lds);
    SEAM(3);
    if (IN(4)) { pg8::Gemm g{C.OG(), C.WT2(), TP, D, E}; pg8::StaticOrder S; S.init(TP, D, (int)gridDim.x, (int)blockIdx.x);
        EpiResid Ep{C.xp(), C.xs(), C.X1()}; if (!(a.flags & 2)) pg8::gemm_phase<EpiResid, pg8::StaticOrder, true, true>(lds, g, S, Ep);
        const int t1 = fresh_tid(), lane = t1 & 63, wave = __builtin_amdgcn_readfirstlane(t1 >> 6), i16 = lane & 15, q4 = lane >> 4;
        if (!(a.flags & 1)) {   float* X1 = C.X1(); const float* xs = C.xs();
            for (int job = blockIdx.x; job < 2 * (D / 16); job += gridDim.x) { const int r0 = TP + wave * 16, c0 = (job >> 1) * 16, kh = (job & 1) * (E / 2);
                skinny_wg<1, 1, E / 2, E>(C.OG() + (size_t)r0 * E + kh, E, C.WT2() + (size_t)c0 * E + kh, lds, t1, 0, job >> 3, [&](int j, const f32x4 v) {
                    float* p = X1 + (size_t)(r0 + i16) * D + c0 + 4 * q4;
                    atomicAdd(p, v[0]); atomicAdd(p + 1, v[1]); atomicAdd(p + 2, v[2]); atomicAdd(p + 3, v[3]); }); } } }
    SEAM(4);
    if (IN(5)) { const int t5 = fresh_tid(), lane = t5 & 63, gw = blockIdx.x * 8 + (t5 >> 6), NGW = gridDim.x * 8; for (int m = gw; m < MV; m += NGW) rms_row_bf16(C.X1() + (size_t)m * D, C.nssm(), C.H() + (size_t)m * D, lane); }
    SEAM(5);
    if (IN(6)) { pg8::Gemm g{C.H(), C.WT3(), TP, NZ, D}; pg8::StaticOrder S; S.init(TP, NZ, (int)gridDim.x, (int)blockIdx.x);
        EpiStore Ep{C.UZ(), NZ}; if (!(a.flags & 2)) pg8::gemm_phase<EpiStore, pg8::StaticOrder, true, true>(lds, g, S, Ep);
        const int t1 = fresh_tid(), lane = t1 & 63, wave = __builtin_amdgcn_readfirstlane(t1 >> 6), i16 = lane & 15, q4 = lane >> 4;
        if (!(a.flags & 1)) {   bf16* UZ = C.UZ();
            for (int job = blockIdx.x; job < NZ / 32; job += gridDim.x) { const int r0 = TP + wave * 16, c0 = job * 32;
                skinny_wg<2, 2, D, D>(C.H() + (size_t)r0 * D, D, C.WT3() + (size_t)c0 * D, lds, t1, 0, job >> 3, [&](int j, const f32x4 v) {
                    *(v2u*)(UZ + (size_t)(r0 + i16) * NZ + c0 + 16 * j + 4 * q4) = pk4(v); }); } } }
    SEAM(6);
    if (IN(7)) phase7(C, lds);
    SEAM(7);
    if (IN(8)) { pg8::Gemm g{C.YG(), C.WT4(), TP, E, E}; pg8::StaticOrder S; S.init(TP, E, (int)gridDim.x, (int)blockIdx.x);
        EpiGlu Ep{C.YG(), C.UZ(), C.bglu(), C.Y2()}; if (!(a.flags & 2)) pg8::gemm_phase<EpiGlu, pg8::StaticOrder, true, true>(lds, g, S, Ep);
        const int t1 = fresh_tid(), lane = t1 & 63, wave = __builtin_amdgcn_readfirstlane(t1 >> 6), i16 = lane & 15, q4 = lane >> 4;
        if (!(a.flags & 1)) {   bf16* Y2 = C.Y2(); const bf16* YG = C.YG(); const bf16* UZ = C.UZ(); const float* bg = C.bglu();
            for (int job = blockIdx.x; job < E / 16; job += gridDim.x) { const int r0 = TP + wave * 16, c0 = job * 16;
                skinny_wg<1, 1, E, E>(YG + (size_t)r0 * E, E, C.WT4() + (size_t)c0 * E, lds, t1, 0, job >> 3, [&](int j, const f32x4 v) {
                    const size_t r = r0 + i16; const int c = c0 + 4 * q4;
                    const v2u yv = *(const v2u*)(YG + r * E + c), zv = *(const v2u*)(UZ + r * NZ + E + c); const f32x4 gt = v + *(const f32x4*)(bg + c);
                    f32x4 o; o[0] = lo_bf(yv.x) * sigmoidf_(gt[0]) * siluf_(lo_bf(zv.x)); o[1] = hi_bf(yv.x) * sigmoidf_(gt[1]) * siluf_(hi_bf(zv.x));
                    o[2] = lo_bf(yv.y) * sigmoidf_(gt[2]) * siluf_(lo_bf(zv.y)); o[3] = hi_bf(yv.y) * sigmoidf_(gt[3]) * siluf_(hi_bf(zv.y));
                    *(v2u*)(Y2 + r * E + c) = pk4(o); }); } } }
    SEAM(8);
    if (IN(9)) { pg8::Gemm g{C.Y2(), C.WT5(), TP, D, E}; pg8::StaticOrder S; S.init(TP, D, (int)gridDim.x, (int)blockIdx.x);
        EpiResid2 Ep{C.X1()}; if (!(a.flags & 2)) pg8::gemm_phase<EpiResid2, pg8::StaticOrder, true, true>(lds, g, S, Ep);
        const int t1 = fresh_tid(), lane = t1 & 63, wave = __builtin_amdgcn_readfirstlane(t1 >> 6), i16 = lane & 15, q4 = lane >> 4;
        if (!(a.flags & 1)) {   float* X1 = C.X1();
            for (int job = blockIdx.x; job < 2 * (D / 16); job += gridDim.x) { const int r0 = TP + wave * 16, c0 = (job >> 1) * 16, kh = (job & 1) * (E / 2);
                skinny_wg<1, 1, E / 2, E>(C.Y2() + (size_t)r0 * E + kh, E, C.WT5() + (size_t)c0 * E + kh, lds, t1, 0, job >> 3, [&](int j, const f32x4 v) {
                    float* p = X1 + (size_t)(r0 + i16) * D + c0 + 4 * q4;
                    atomicAdd(p, v[0]); atomicAdd(p + 1, v[1]); atomicAdd(p + 2, v[2]); atomicAdd(p + 3, v[3]); }); } } }
    SEAM(9);
    if (IN(10)) { const int t10 = fresh_tid(), lane = t10 & 63, gw = blockIdx.x * 8 + (t10 >> 6), NGW = gridDim.x * 8; for (int m = gw; m < MV; m += NGW) rms_row_f32(C.X1() + (size_t)m * D, C.nfin(), m < TP ? C.out() + O_YP + (size_t)m * D : C.out() + O_YS + (size_t)(m - TP) * D, lane); }
}

#ifndef MK_SPLIT
#define MK_SPLIT 0
#endif
extern "C" void kernel_launch(void* const* d_in, const int* in_sizes, int n_in, void* d_out, int out_size, void* d_ws, size_t ws_size, hipStream_t stream) {
    static int grid = 0;
    if (grid == 0) {
        if (n_in != 27 || (size_t)out_size != O_END || ws_size < WS_END) { fprintf(stderr, "kernel_launch: unexpected problem (n_in %d, out %d, ws %zu)\n", n_in, out_size, ws_size); grid = -1; return; }
        int dev = 0, cus = 0, per_cu = 0;
        if (hipGetDevice(&dev) != hipSuccess || hipDeviceGetAttribute(&cus, hipDeviceAttributeMultiprocessorCount, dev) != hipSuccess) { grid = -1; return; }
        if (hipFuncSetAttribute((const void*)mk_fwd, hipFuncAttributeMaxDynamicSharedMemorySize, LDS_BYTES) != hipSuccess) { fprintf(stderr, "kernel_launch: hipFuncSetAttribute failed\n"); grid = -1; return; }
        if (hipOccupancyMaxActiveBlocksPerMultiprocessor(&per_cu, (const void*)mk_fwd, 512, LDS_BYTES) != hipSuccess || per_cu < 1) { fprintf(stderr, "kernel_launch: occupancy query says %d\n", per_cu); (void)hipGetLastError(); grid = -1; return; }
        grid = cus;
    }
    if (grid < 0) return;
    (void)hipMemsetAsync((char*)d_ws + WS_CTL, 0, 4096, stream);
    Args a{};
    for (int i = 0; i < 27; ++i) a.in[i] = (const float*)d_in[i];
    a.out = (float*)d_out; a.ws = (unsigned char*)d_ws;
#if MK_SPLIT
    for (int p = 0; p <= 10; ++p) { a.ph_lo = p; a.ph_hi = p + 1; hipLaunchKernelGGL(mk_fwd, dim3(grid), dim3(512), LDS_BYTES, stream, a); }
#else
    a.ph_lo = 0; a.ph_hi = 11;
    void* args[] = {&a};
    hipError_t e = hipLaunchCooperativeKernel((const void*)mk_fwd, dim3(grid), dim3(512), args, LDS_BYTES, stream);
    if (e != hipSuccess) fprintf(stderr, "kernel_launch: cooperative launch failed: %s (grid %d)\n", hipGetErrorString(e), grid);
#endif
#ifdef PROBE_EXTRA
    for (int p = 0; p <= 11; ++p) if ((PROBE_EXTRA >> p) & 1) {
        if (p == 3) (void)hipMemsetAsync((char*)d_ws + WS_CTL, 0, 4096, stream);
        a.ph_lo = p; a.ph_hi = p + 1; a.out = (float*)((char*)d_ws + 64 * MiB);
#ifdef PROBE_FLAGS
        a.flags = PROBE_FLAGS;
#endif
        hipLaunchKernelGGL(mk_fwd, dim3(grid), dim3(512), LDS_BYTES, stream, a); }
#endif
}
```
